# Optimizing an MI355X kernel written in HIP

```python
import math
import jax, jax.numpy as jnp
from jax import lax
import numpy as np

D_MODEL = 1024
BATCH = 4
SEQ = 8192
DEPTH = 1

N_Q_HEADS = 8
N_KV_HEADS = 2
GROUP = N_Q_HEADS // N_KV_HEADS
HEAD_DIM = 64
WINDOW = 128
BLOCK = 128
Q_W = N_Q_HEADS * HEAD_DIM
KV_W = N_KV_HEADS * HEAD_DIM
N_BUCKETS = 32
MAX_DISTANCE = 128
GMLP_GROUPS = 8
GMLP_GROUP_DIM = 64
GMLP_WIDTH = GMLP_GROUPS * GMLP_GROUP_DIM
CHUNK = 128
N_BRANCHES = 2
IN_W = Q_W + 2 * KV_W + 2 * GMLP_WIDTH + N_BRANCHES * D_MODEL
D_FF = 2816
FFN_RES = 0.5
N_SUB = 3
N_ADA = 3 * N_SUB
EPS = 1e-6
NEG = -1e30

kernel_name = "hybrid_swa_sink_gmlp_macaron_block"


def rmsnorm(x, g):
    xf = x.astype(jnp.float32)
    r = lax.rsqrt(jnp.mean(xf * xf, axis=-1, keepdims=True) + EPS)
    return (xf * r * g.astype(jnp.float32)).astype(x.dtype)


def layernorm(x, g, b):
    xf = x.astype(jnp.float32)
    mu = jnp.mean(xf, axis=-1, keepdims=True)
    var = jnp.mean(jnp.square(xf - mu), axis=-1, keepdims=True)
    return ((xf - mu) * lax.rsqrt(var + EPS) * g + b).astype(x.dtype)


def modulate(x, shift, scale):
    return x * (1.0 + scale[:, None, :]) + shift[:, None, :]


def swiglu(x, w_in, w_out):
    gu = x @ w_in
    gate, up = jnp.split(gu, 2, axis=-1)
    return (jax.nn.silu(gate) * up) @ w_out


def t5_causal_bucket(dist):
    max_exact = N_BUCKETS // 2
    d_f = jnp.maximum(dist, max_exact).astype(jnp.float32)
    large = max_exact + (jnp.log(d_f / max_exact) / math.log(MAX_DISTANCE / max_exact)
                         * (N_BUCKETS - max_exact)).astype(jnp.int32)
    large = jnp.minimum(large, N_BUCKETS - 1)
    return jnp.where(dist < max_exact, dist, large)


def banded_sink_attention(q, k, v, sinks, rel_table):
    B, S, _ = q.shape
    nb = S // BLOCK
    q = q.reshape(B, nb, BLOCK, N_KV_HEADS, GROUP, HEAD_DIM)
    k = k.reshape(B, nb, BLOCK, N_KV_HEADS, HEAD_DIM)
    v = v.reshape(B, nb, BLOCK, N_KV_HEADS, HEAD_DIM)
    pad = ((0, 0), (1, 0), (0, 0), (0, 0), (0, 0))
    kk = jnp.concatenate([jnp.pad(k, pad)[:, :-1], k], axis=2)
    vv = jnp.concatenate([jnp.pad(v, pad)[:, :-1], v], axis=2)

    qi = jnp.arange(BLOCK, dtype=jnp.int32)[:, None]
    kj = jnp.arange(2 * BLOCK, dtype=jnp.int32)[None, :]
    dist = qi + BLOCK - kj
    in_window = (dist >= 0) & (dist < WINDOW)
    blk = jnp.arange(nb, dtype=jnp.int32)[:, None, None]
    key_pos = (blk - 1) * BLOCK + kj[None]
    mask = in_window[None] & (key_pos >= 0)
    bias = rel_table.astype(jnp.float32)[t5_causal_bucket(jnp.maximum(dist, 0))]
    bias = jnp.transpose(bias, (2, 0, 1)).reshape(N_KV_HEADS, GROUP, BLOCK, 2 * BLOCK)

    s = jnp.einsum('bnqkgd,bnskd->bnkgqs', q, kk,
                   preferred_element_type=jnp.float32) * (HEAD_DIM ** -0.5)
    s = s + bias[None, None]
    s = jnp.where(mask[None, :, None, None], s, NEG)
    sink = sinks.astype(jnp.float32).reshape(1, 1, N_KV_HEADS, GROUP, 1, 1)
    m = jnp.maximum(jnp.max(s, axis=-1, keepdims=True), sink)
    p = jnp.exp(s - m)
    denom = jnp.sum(p, axis=-1, keepdims=True) + jnp.exp(sink - m)
    o = jnp.einsum('bnkgqs,bnskd->bnqkgd', (p / denom).astype(vv.dtype), vv,
                   preferred_element_type=jnp.float32)
    return o.astype(q.dtype).reshape(B, S, Q_W)


def chunked_spatial_gating(z, ln_g, ln_b, w_s, b_s):
    z = jax.nn.gelu(z)
    u, vg = jnp.split(z, 2, axis=-1)
    vg = layernorm(vg, ln_g, ln_b)
    B, S, _ = vg.shape
    nc = S // CHUNK
    vg = vg.reshape(B, nc, CHUNK, GMLP_GROUPS, GMLP_GROUP_DIM)
    causal = jnp.tril(jnp.ones((CHUNK, CHUNK), dtype=w_s.dtype))
    w = w_s * causal[None]
    sp = jnp.einsum('gts,bnsgc->bntgc', w, vg)
    sp = sp + jnp.transpose(b_s)[None, None, :, :, None]
    return u * sp.reshape(B, S, GMLP_WIDTH)


def setup_inputs(seed: int = 0) -> dict:
    key = jax.random.key(seed)
    ks = jax.random.split(key, 24)
    f32 = jnp.float32
    nrm = lambda k, shape, scale: jax.random.normal(k, shape, f32) * scale
    L = DEPTH
    return {
        "x": nrm(ks[0], (BATCH, SEQ, D_MODEL), 1.0),
        "c": nrm(ks[1], (BATCH, D_MODEL), 1.0),
        "rel_bias": nrm(ks[2], (N_BUCKETS, N_Q_HEADS), 0.5),
        "w_ada": nrm(ks[3], (L, D_MODEL, N_ADA * D_MODEL), 0.5 * D_MODEL ** -0.5),
        "b_ada": nrm(ks[4], (L, N_ADA * D_MODEL), 0.02),
        "pre_norm_g": 1.0 + nrm(ks[5], (L, N_SUB, D_MODEL), 0.05),
        "post_norm_g": 1.0 + nrm(ks[6], (L, N_SUB, D_MODEL), 0.05),
        "w_ffn1_in": nrm(ks[7], (L, D_MODEL, 2 * D_FF), D_MODEL ** -0.5),
        "w_ffn1_out": nrm(ks[8], (L, D_FF, D_MODEL), D_FF ** -0.5),
        "w_in": nrm(ks[9], (L, D_MODEL, IN_W), D_MODEL ** -0.5),
        "sinks": nrm(ks[10], (L, N_Q_HEADS), 1.0),
        "gmlp_ln_g": 1.0 + nrm(ks[11], (L, GMLP_WIDTH), 0.05),
        "gmlp_ln_b": nrm(ks[12], (L, GMLP_WIDTH), 0.02),
        "gmlp_w_s": nrm(ks[13], (L, GMLP_GROUPS, CHUNK, CHUNK), CHUNK ** -0.5),
        "gmlp_b_s": 1.0 + nrm(ks[14], (L, GMLP_GROUPS, CHUNK), 0.02),
        "w_br_attn": nrm(ks[15], (L, Q_W, D_MODEL), Q_W ** -0.5),
        "w_br_gmlp": nrm(ks[16], (L, GMLP_WIDTH, D_MODEL), GMLP_WIDTH ** -0.5),
        "w_out": nrm(ks[17], (L, D_MODEL, D_MODEL), D_MODEL ** -0.5),
        "w_ffn2_in": nrm(ks[18], (L, D_MODEL, 2 * D_FF), D_MODEL ** -0.5),
        "w_ffn2_out": nrm(ks[19], (L, D_FF, D_MODEL), D_FF ** -0.5),
    }


def reference(x, c, rel_bias, w_ada, b_ada, pre_norm_g, post_norm_g, w_ffn1_in, w_ffn1_out,
              w_in, sinks, gmlp_ln_g, gmlp_ln_b, gmlp_w_s, gmlp_b_s, w_br_attn, w_br_gmlp,
              w_out, w_ffn2_in, w_ffn2_out):
    h = x
    splits = np.cumsum([Q_W, KV_W, KV_W, 2 * GMLP_WIDTH]).tolist()
    for l in range(DEPTH):
        ada = jax.nn.silu(c) @ w_ada[l] + b_ada[l]
        sh1, sc1, g1, sh2, sc2, g2, sh3, sc3, g3 = jnp.split(ada, N_ADA, axis=-1)

        n = modulate(rmsnorm(h, pre_norm_g[l, 0]), sh1, sc1)
        y = swiglu(n, w_ffn1_in[l], w_ffn1_out[l])
        h = h + FFN_RES * g1[:, None, :] * rmsnorm(y, post_norm_g[l, 0])

        n = modulate(rmsnorm(h, pre_norm_g[l, 1]), sh2, sc2)
        z = n @ w_in[l]
        q, k, v, zg, zgate = jnp.split(z, splits, axis=-1)
        ya = banded_sink_attention(q, k, v, sinks[l], rel_bias) @ w_br_attn[l]
        yg = chunked_spatial_gating(zg, gmlp_ln_g[l], gmlp_ln_b[l],
                                    gmlp_w_s[l], gmlp_b_s[l]) @ w_br_gmlp[l]
        ga, gg = jnp.split(jax.nn.sigmoid(zgate), N_BRANCHES, axis=-1)
        y = (ga * ya + gg * yg) @ w_out[l]
        h = h + g2[:, None, :] * rmsnorm(y, post_norm_g[l, 1])

        n = modulate(rmsnorm(h, pre_norm_g[l, 2]), sh3, sc3)
        y = swiglu(n, w_ffn2_in[l], w_ffn2_out[l])
        h = h + FFN_RES * g3[:, None, :] * rmsnorm(y, post_norm_g[l, 2])
    return h
```

```cpp
#include <hip/hip_runtime.h>
#include <cstdio>
#include <cstdint>


namespace pg8 {
#define PG8_LAS __attribute__((address_space(3)))
typedef unsigned short bf16_t;
typedef short bf16x8 __attribute__((ext_vector_type(8)));
typedef float f32x4 __attribute__((ext_vector_type(4)));
typedef unsigned u32x4 __attribute__((ext_vector_type(4)));
constexpr int BM = 256, BK = 64, HALF = 128, HTB = HALF * BK * 2  , STAGE_BYTES = 8 * HTB, NXCD = 8, WGM = 8;

__host__ __device__ __forceinline__ int lds_byte(int r, int c) { const int st = (r >> 4) * 2 + (c >> 5), rr = r & 15, cc = c & 31, ob = rr * 64 + cc * 2; return st * 1024 + (ob ^ (((ob >> 9) & 1) << 5)); }
__host__ __device__ __forceinline__ void stage_rc(int b, int& R, int& C) { const int st = b / 1024, sb = b % 1024, swz = sb ^ (((sb >> 9) & 1) << 5); R = (st >> 1) * 16 + swz / 64; C = (st & 1) * 32 + (swz % 64) / 2; }
__host__ __device__ __forceinline__ int perm32(int rho) { const int n = rho >> 4, i = rho & 15; return 8 * (i >> 2) + 4 * n + (i & 3); }

struct Unit { int pm, pn, seg; };
struct Gemm { const bf16_t* A; const bf16_t* Bt; int M, N, K, lda, ldb, segoff; };

struct StaticOrder {
    int nM, nN, nwg, G, c;
    __host__ __device__ void init(int M, int N, int G_, int c_) { nM = M / BM; nN = N / BM; nwg = nM * nN; G = G_; c = c_; }
    __host__ __device__ bool next(int i, Unit& u) const {
        const long L = (long)i * G + c; if (L >= nwg) return false;
        int wgid = (int)L; { const int q = nwg / NXCD, r = nwg % NXCD, xcd = wgid % NXCD, off = wgid / NXCD; wgid = (xcd < r ? xcd * (q + 1) : r * (q + 1) + (xcd - r) * q) + off; }
        const int nig = WGM * nN, gid = wgid / nig, fm = gid * WGM, gsz = (nM - fm) < WGM ? (nM - fm) : WGM;
        u.pm = fm + ((wgid % nig) % gsz); u.pn = (wgid % nig) / gsz; u.seg = 0; return true;
    }
    __device__ __forceinline__ void a_ready(const Unit&) const {}
    __device__ __forceinline__ void done(const Unit&) const {}
};
typedef float f32x2_cv __attribute__((ext_vector_type(2))); typedef __bf16 bf16x2_cv __attribute__((ext_vector_type(2)));
__device__ __forceinline__ unsigned cvt_pk_bf16(float lo, float hi) { f32x2_cv v = {lo, hi}; bf16x2_cv b = __builtin_convertvector(v, bf16x2_cv); return __builtin_bit_cast(unsigned, b); }
typedef float f32x2 __attribute__((ext_vector_type(2)));
__device__ __forceinline__ float bf_lo(unsigned w) { return __uint_as_float(w << 16); }
__device__ __forceinline__ float bf_hi(unsigned w) { return __uint_as_float(w & 0xffff0000u); }
__device__ __forceinline__ float sigm(float x) { return __builtin_amdgcn_rcpf(1.f + __builtin_amdgcn_exp2f(-1.4426950408889634f * x)); }
__device__ __forceinline__ float gelu_t(float x) { const float u2 = 1.5957691216057308f * (x + 0.044715f * x * x * x); return x * sigm(u2); }
__device__ __forceinline__ u32x4 pack8(const f32x4& a, const f32x4& b) { u32x4 w; w.x = cvt_pk_bf16(a[0], a[1]); w.y = cvt_pk_bf16(a[2], a[3]); w.z = cvt_pk_bf16(b[0], b[1]); w.w = cvt_pk_bf16(b[2], b[3]); return w; }

struct EpiSwiglu {
    static constexpr bool PERM = true, AFTER_DRAIN = false;
    bf16_t* O; int ldc;
    __device__ __forceinline__ void operator()(f32x4 (&acc)[2][2][4][2], const Unit& u, int wr, int wc, int fr, int fq) const {
        const int row0 = u.pm * BM + wr * 64 + fr, col0 = u.pn * HALF + wc * 32 + 8 * fq;
#pragma unroll
        for (int ai = 0; ai < 2; ++ai)
#pragma unroll
            for (int m = 0; m < 4; ++m) {
                bf16_t* p = O + (size_t)(row0 + ai * HALF + m * 16) * ldc + col0;
                f32x4 v0, v1;
#pragma unroll
                for (int e = 0; e < 4; ++e) { const float g0 = acc[ai][0][m][0][e], g1 = acc[ai][0][m][1][e];
                    v0[e] = g0 * sigm(g0) * acc[ai][1][m][0][e]; v1[e] = g1 * sigm(g1) * acc[ai][1][m][1][e]; }
                *(u32x4*)p = pack8(v0, v1);
            }
    }
};
struct EpiZ {
    static constexpr bool PERM = true, AFTER_DRAIN = false;
    bf16_t *QKV, *ZG, *GATE;
    template <int KIND> __device__ __forceinline__ void tile(f32x4 (&acc)[2][2][4][2], bf16_t* base, int ldc, int row0, int col0) const {
#pragma unroll
        for (int ai = 0; ai < 2; ++ai)
#pragma unroll
            for (int m = 0; m < 4; ++m) {
                bf16_t* p = base + (size_t)(row0 + ai * HALF + m * 16) * ldc + col0;
#pragma unroll
                for (int bj = 0; bj < 2; ++bj) {
                    f32x4 v0 = acc[ai][bj][m][0], v1 = acc[ai][bj][m][1];
#pragma unroll
                    for (int e = 0; e < 4; ++e) {
                        if (KIND == 0) { v0[e] *= 0.125f; v1[e] *= 0.125f; }
                        if (KIND == 2) { v0[e] = gelu_t(v0[e]); v1[e] = gelu_t(v1[e]); }
                        if (KIND == 3) { v0[e] = sigm(v0[e]); v1[e] = sigm(v1[e]); }
                    }
                    *(u32x4*)(p + bj * HALF) = pack8(v0, v1);
                }
            }
    }
    __device__ __forceinline__ void operator()(f32x4 (&acc)[2][2][4][2], const Unit& u, int wr, int wc, int fr, int fq) const {
        const int pn = u.pn, row0 = u.pm * BM + wr * 64 + fr, cw = wc * 32 + 8 * fq;
        if (pn < 2) tile<0>(acc, QKV, 768, row0, pn * 256 + cw);
        else if (pn == 2) tile<1>(acc, QKV, 768, row0, 512 + cw);
        else if (pn < 7) tile<2>(acc, ZG, 1024, row0, (pn - 3) * 256 + cw);
        else tile<3>(acc, GATE, 2048, row0, (pn - 7) * 256 + cw);
    }
};
struct EpiF32 {
    static constexpr bool PERM = false, AFTER_DRAIN = false;
    float* O; int ldc;
    __device__ __forceinline__ void operator()(f32x4 (&acc)[2][2][4][2], const Unit& u, int wr, int wc, int fr, int fq) const {
        const int row0 = u.pm * BM + wr * 64 + fr, col0 = u.pn * BM + wc * 32 + 4 * fq;
#pragma unroll
        for (int ai = 0; ai < 2; ++ai)
#pragma unroll
            for (int m = 0; m < 4; ++m) { float* p = O + (size_t)(row0 + ai * HALF + m * 16) * ldc + col0;
#pragma unroll
                for (int bj = 0; bj < 2; ++bj)
#pragma unroll
                    for (int n = 0; n < 2; ++n) *(f32x4*)(p + bj * HALF + n * 16) = acc[ai][bj][m][n]; }
    }
};
struct EpiBr {
    static constexpr bool PERM = true, AFTER_DRAIN = false;
    const bf16_t* GATE; bf16_t* O;
    __device__ __forceinline__ void operator()(f32x4 (&acc)[2][2][4][2], const Unit& u, int wr, int wc, int fr, int fq) const {
        const int row0 = u.pm * BM + wr * 64 + fr, col0 = u.pn * BM + wc * 32 + 8 * fq;
        if (u.seg == 0) {
#if !defined(EXP_NOGATE)
#pragma unroll
            for (int ai = 0; ai < 2; ++ai)
#pragma unroll
                for (int m = 0; m < 4; ++m) { const bf16_t* gp = GATE + (size_t)(row0 + ai * HALF + m * 16) * 2048 + col0;
#pragma unroll
                    for (int bj = 0; bj < 2; ++bj) {
                        const u32x4 ga = *(const u32x4*)(gp + bj * HALF), gg = *(const u32x4*)(gp + 1024 + bj * HALF);
                        f32x4 r0, r1;
                        r0[0] = bf_lo(ga.x) * __builtin_amdgcn_rcpf(fmaxf(bf_lo(gg.x), 1e-30f)); r0[1] = bf_hi(ga.x) * __builtin_amdgcn_rcpf(fmaxf(bf_hi(gg.x), 1e-30f));
                        r0[2] = bf_lo(ga.y) * __builtin_amdgcn_rcpf(fmaxf(bf_lo(gg.y), 1e-30f)); r0[3] = bf_hi(ga.y) * __builtin_amdgcn_rcpf(fmaxf(bf_hi(gg.y), 1e-30f));
                        r1[0] = bf_lo(ga.z) * __builtin_amdgcn_rcpf(fmaxf(bf_lo(gg.z), 1e-30f)); r1[1] = bf_hi(ga.z) * __builtin_amdgcn_rcpf(fmaxf(bf_hi(gg.z), 1e-30f));
                        r1[2] = bf_lo(ga.w) * __builtin_amdgcn_rcpf(fmaxf(bf_lo(gg.w), 1e-30f)); r1[3] = bf_hi(ga.w) * __builtin_amdgcn_rcpf(fmaxf(bf_hi(gg.w), 1e-30f));
                        acc[ai][bj][m][0] *= r0; acc[ai][bj][m][1] *= r1;
                    }
                    if (m & 1) asm volatile("" ::: "memory"); }
#endif
        } else {
#pragma unroll
            for (int ai = 0; ai < 2; ++ai)
#pragma unroll
                for (int m = 0; m < 4; ++m) { const size_t ro = (size_t)(row0 + ai * HALF + m * 16);
#pragma unroll
                    for (int bj = 0; bj < 2; ++bj) {
#if defined(EXP_NOGATE)
                        const u32x4 gg = (u32x4){0x3f803f80u, 0x3f803f80u, 0x3f803f80u, 0x3f803f80u};
#else
                        const u32x4 gg = *(const u32x4*)(GATE + ro * 2048 + 1024 + col0 + bj * HALF);
#endif
                        f32x4 v0 = acc[ai][bj][m][0], v1 = acc[ai][bj][m][1];
                        v0[0] *= bf_lo(gg.x); v0[1] *= bf_hi(gg.x); v0[2] *= bf_lo(gg.y); v0[3] *= bf_hi(gg.y);
                        v1[0] *= bf_lo(gg.z); v1[1] *= bf_hi(gg.z); v1[2] *= bf_lo(gg.w); v1[3] *= bf_hi(gg.w);
                        *(u32x4*)(O + ro * 1024 + col0 + bj * HALF) = pack8(v0, v1);
                    }
                    if (m & 1) asm volatile("" ::: "memory"); }
        }
    }
};
struct SegOrder {
    StaticOrder S;
    __device__ __forceinline__ bool next(int i, Unit& u) const { if (!S.next(i >> 1, u)) return false; u.seg = i & 1; return true; }
    __device__ __forceinline__ void a_ready(const Unit&) const {}
    __device__ __forceinline__ void done(const Unit&) const {}
};

template <class Epi, class Sched, bool ALIGN_EPI = false, bool SP2 = false>
__device__ __forceinline__ void gemm_phase(PG8_LAS unsigned char* lds, const Gemm g, const Sched& S, const Epi& E) {
    const int tid = threadIdx.x, wid = __builtin_amdgcn_readfirstlane(tid >> 6), lane = tid & 63, wr = wid >> 2, wc = wid & 3, fr = lane & 15, fq = lane >> 4;
    const int K = g.K, nt = K / BK;
    unsigned voffA[2], voffB[2];
#pragma unroll
    for (int i = 0; i < 2; ++i) { int R, C; stage_rc(tid * 16 + i * 8192, R, C); const int Rb = Epi::PERM ? ((R & ~31) + perm32(R & 31)) : R;
        voffA[i] = (unsigned)(R * g.lda + C) * 2u; voffB[i] = (unsigned)(Rb * g.ldb + C) * 2u; }
    const size_t kstep = (size_t)(BK * 2);
    const size_t hstepA = (size_t)HALF * g.lda * 2, hstepB = (size_t)HALF * g.ldb * 2;
    const size_t tstepA = 2 * hstepA, tstepB = 2 * hstepB;
    const unsigned ldsw = (unsigned)wid * 1024u;
    const int aoff = lds_byte(wr * 64 + fr, fq * 8), boff = lds_byte(wc * 32 + fr, fq * 8);
#define PG8_SA(b, h) (((b) * 2 + (h)) * HTB)
#define PG8_SB(b, h) ((4 + (b) * 2 + (h)) * HTB)
#define PG8_STAGE(bufoff, gbase, voff) do { _Pragma("unroll") for (int _i = 0; _i < 2; ++_i) \
        __builtin_amdgcn_global_load_lds((const unsigned*)((const char*)(gbase) + (voff)[_i]), (PG8_LAS unsigned*)(lds + (bufoff) + ldsw + _i * 8192), 16, 0, 0); } while (0)
#define PG8_LDA(dst, b, h) do { _Pragma("unroll") for (int m = 0; m < 4; ++m) _Pragma("unroll") for (int k = 0; k < 2; ++k) dst[m][k] = *(const PG8_LAS bf16x8*)(lds + PG8_SA(b, h) + aoff + m * 2048 + k * 1024); } while (0)
#define PG8_LDB(dst, b, h) do { _Pragma("unroll") for (int n = 0; n < 2; ++n) _Pragma("unroll") for (int k = 0; k < 2; ++k) dst[n][k] = *(const PG8_LAS bf16x8*)(lds + PG8_SB(b, h) + boff + n * 2048 + k * 1024); } while (0)
#define PG8_MMA(ai, bj, At, Bt) do { __builtin_amdgcn_s_setprio(1); _Pragma("unroll") for (int m = 0; m < 4; ++m) _Pragma("unroll") for (int n = 0; n < 2; ++n) _Pragma("unroll") for (int k = 0; k < 2; ++k) \
        acc[ai][bj][m][n] = __builtin_amdgcn_mfma_f32_16x16x32_bf16(Bt[n][k], At[m][k], acc[ai][bj][m][n], 0, 0, 0); __builtin_amdgcn_s_setprio(0); } while (0)
#define PG8_WAIT_V(n) asm volatile("s_waitcnt vmcnt(" #n ")" ::: "memory")
#define PG8_WAIT_L(n) asm volatile("s_waitcnt lgkmcnt(" #n ")" ::: "memory")
#define PG8_BAR __builtin_amdgcn_s_barrier()
#define PG8_SCHED __builtin_amdgcn_sched_barrier(0)
    Unit cur, nxt; int ui = 0;
    if (!S.next(0, cur)) return;
    f32x4 acc[2][2][4][2];
#pragma unroll
    for (int a = 0; a < 2; ++a)
#pragma unroll
        for (int b = 0; b < 2; ++b)
#pragma unroll
            for (int m = 0; m < 4; ++m)
#pragma unroll
                for (int n = 0; n < 2; ++n) acc[a][b][m][n] = (f32x4){0.f, 0.f, 0.f, 0.f};
    bf16x8 At[4][2], B0[2][2], B1[2][2];
    const char* cA = (const char*)g.A + (size_t)cur.pm * tstepA + (size_t)cur.seg * g.segoff; const char* cB = (const char*)g.Bt + (size_t)cur.pn * tstepB + (size_t)cur.seg * g.segoff;
    S.a_ready(cur);
    if constexpr (SP2) {
        PG8_STAGE(PG8_SB(0, 0), cB, voffB); PG8_STAGE(PG8_SB(0, 1), cB + hstepB, voffB); PG8_STAGE(PG8_SA(0, 0), cA, voffA); PG8_STAGE(PG8_SA(0, 1), cA + hstepA, voffA);
        if (wr == 1) PG8_BAR;
        PG8_WAIT_V(2); PG8_BAR;
        PG8_STAGE(PG8_SB(1, 0), cB + kstep, voffB); PG8_STAGE(PG8_SA(1, 0), cA + kstep, voffA); PG8_STAGE(PG8_SB(1, 1), cB + hstepB + kstep, voffB);
        PG8_WAIT_V(6); PG8_BAR;
    } else {
        PG8_STAGE(PG8_SB(0, 0), cB, voffB); PG8_STAGE(PG8_SA(0, 0), cA, voffA); PG8_STAGE(PG8_SB(0, 1), cB + hstepB, voffB); PG8_STAGE(PG8_SA(0, 1), cA + hstepA, voffA);
        if (wr == 1) PG8_BAR;
        PG8_WAIT_V(4); PG8_BAR;
        PG8_STAGE(PG8_SB(1, 0), cB + kstep, voffB); PG8_STAGE(PG8_SA(1, 0), cA + kstep, voffA); PG8_STAGE(PG8_SB(1, 1), cB + hstepB + kstep, voffB);
        PG8_WAIT_V(6); PG8_BAR;
    }
    for (;;) {
        const bool has_next = S.next(ui + 1, nxt);
        const char* nA = has_next ? (const char*)g.A + (size_t)nxt.pm * tstepA + (size_t)nxt.seg * g.segoff : cA; const char* nB = has_next ? (const char*)g.Bt + (size_t)nxt.pn * tstepB + (size_t)nxt.seg * g.segoff : cB;
        for (int t = 0; t < nt; t += 2) {
            const bool last = (t == nt - 2);
            const char* a1 = cA + (size_t)(t + 1) * kstep;
            const char* a2 = last ? nA : cA + (size_t)(t + 2) * kstep; const char* b2 = last ? nB : cB + (size_t)(t + 2) * kstep;
            const char* a3 = a2 + kstep; const char* b3 = b2 + kstep;
            if (last && has_next) S.a_ready(nxt);
            if constexpr (SP2) {
            PG8_LDB(B0, 0, 0); PG8_LDB(B1, 0, 1); PG8_SCHED; PG8_LDA(At, 0, 0); PG8_STAGE(PG8_SA(1, 1), a1 + hstepA, voffA);
            PG8_WAIT_V(8); PG8_WAIT_L(0); PG8_BAR; PG8_MMA(0, 0, At, B0); PG8_MMA(0, 1, At, B1); PG8_BAR; PG8_SCHED;
            PG8_LDA(At, 0, 1); PG8_STAGE(PG8_SB(0, 0), b2, voffB); PG8_STAGE(PG8_SB(0, 1), b2 + hstepB, voffB); PG8_STAGE(PG8_SA(0, 0), a2, voffA);
            PG8_WAIT_V(8); PG8_WAIT_L(0); PG8_BAR; PG8_MMA(1, 0, At, B0); PG8_MMA(1, 1, At, B1); PG8_BAR; PG8_SCHED;
            PG8_LDB(B0, 1, 0); PG8_LDB(B1, 1, 1); PG8_SCHED; PG8_LDA(At, 1, 0); PG8_STAGE(PG8_SA(0, 1), a2 + hstepA, voffA);
            PG8_WAIT_V(8); PG8_WAIT_L(0); PG8_BAR; PG8_MMA(0, 0, At, B0); PG8_MMA(0, 1, At, B1); PG8_BAR; PG8_SCHED;
            PG8_LDA(At, 1, 1); PG8_STAGE(PG8_SB(1, 0), b3, voffB); PG8_STAGE(PG8_SB(1, 1), b3 + hstepB, voffB); PG8_STAGE(PG8_SA(1, 0), a3, voffA);
            PG8_WAIT_V(8); PG8_WAIT_L(0); PG8_BAR; PG8_MMA(1, 0, At, B0); PG8_MMA(1, 1, At, B1); PG8_BAR; PG8_SCHED;
            } else {
            PG8_LDB(B0, 0, 0); PG8_SCHED; PG8_LDA(At, 0, 0); PG8_STAGE(PG8_SA(1, 1), a1 + hstepA, voffA);
            PG8_WAIT_L(8); PG8_BAR; PG8_WAIT_L(0); PG8_MMA(0, 0, At, B0); PG8_BAR; PG8_SCHED;
            PG8_LDB(B1, 0, 1); PG8_STAGE(PG8_SB(0, 0), b2, voffB);
            PG8_BAR; PG8_WAIT_L(0); PG8_MMA(0, 1, At, B1); PG8_BAR;
            PG8_LDA(At, 0, 1); PG8_STAGE(PG8_SA(0, 0), a2, voffA);
            PG8_BAR; PG8_WAIT_L(0); PG8_MMA(1, 0, At, B0); PG8_BAR; PG8_SCHED;
            PG8_STAGE(PG8_SB(0, 1), b2 + hstepB, voffB);
            PG8_WAIT_V(6); PG8_BAR; PG8_MMA(1, 1, At, B1); PG8_BAR;
            PG8_LDB(B0, 1, 0); PG8_SCHED; PG8_LDA(At, 1, 0); PG8_STAGE(PG8_SA(0, 1), a2 + hstepA, voffA);
            PG8_WAIT_L(8); PG8_BAR; PG8_WAIT_L(0); PG8_MMA(0, 0, At, B0); PG8_BAR; PG8_SCHED;
            PG8_LDB(B1, 1, 1); PG8_STAGE(PG8_SB(1, 0), b3, voffB);
            PG8_BAR; PG8_WAIT_L(0); PG8_MMA(0, 1, At, B1); PG8_BAR;
            PG8_LDA(At, 1, 1); PG8_STAGE(PG8_SA(1, 0), a3, voffA);
            PG8_BAR; PG8_WAIT_L(0); PG8_MMA(1, 0, At, B0); PG8_BAR; PG8_SCHED;
            PG8_STAGE(PG8_SB(1, 1), b3 + hstepB, voffB);
            PG8_WAIT_V(6); PG8_BAR; PG8_MMA(1, 1, At, B1); PG8_BAR;
            }
        }
        if constexpr (ALIGN_EPI) { if (wr == 0) PG8_BAR; }
        if constexpr (!Epi::AFTER_DRAIN) { E(acc, cur, wr, wc, fr, fq); S.done(cur); }
        if (!has_next) break;
        if (nxt.seg == 0)
#pragma unroll
        for (int a = 0; a < 2; ++a)
#pragma unroll
            for (int b = 0; b < 2; ++b)
#pragma unroll
                for (int m = 0; m < 4; ++m)
#pragma unroll
                    for (int n = 0; n < 2; ++n) acc[a][b][m][n] = (f32x4){0.f, 0.f, 0.f, 0.f};
        cur = nxt; cA = nA; cB = nB; ++ui;
        if constexpr (ALIGN_EPI) { if (wr == 1) PG8_BAR; }
    }
    PG8_WAIT_V(0);
    if constexpr (!ALIGN_EPI) { if (wr == 0) PG8_BAR; }
    PG8_BAR;
    if constexpr (Epi::AFTER_DRAIN) { E.fused(acc, cur, wr, wc, fr, fq, lds, wid, lane); S.done(cur); }
#undef PG8_SA
#undef PG8_SB
#undef PG8_STAGE
#undef PG8_LDA
#undef PG8_LDB
#undef PG8_MMA
#undef PG8_WAIT_V
#undef PG8_WAIT_L
#undef PG8_BAR
#undef PG8_SCHED
}
}

constexpr int NWAVES = 8, NTHREADS = 512;
constexpr int BATCH = 4, SEQ = 8192, D = 1024, M = BATCH * SEQ, DFF = 2816, NFI = 2 * DFF, INW = 3840, NADA = 9 * D;
constexpr float EPS = 1e-6f;
#ifndef MK_N_LAUNCHES
#define MK_N_LAUNCHES 1
#endif
#ifndef DBG_STOP
#define DBG_STOP 13
#endif
#ifndef DBG_DUMP
#define DBG_DUMP 0
#endif
constexpr int N_PHASES = 13;
constexpr int N_LAUNCHES = MK_N_LAUNCHES;
constexpr size_t MiB = 1u << 20;
constexpr size_t WS_CTL = 0, CTL_ZERO_BYTES = 1 * MiB;
constexpr size_t WS_ADA = 1 * MiB, WS_DV = 1 * MiB + 256 * 1024, WS_WSM = 1 * MiB + 512 * 1024, WS_X = 2 * MiB;
constexpr size_t WS_W1I = 4 * MiB, WS_W1O = 15 * MiB, WS_WIN = 21 * MiB, WS_WBR = 29 * MiB, WS_WOUT = 31 * MiB, WS_W2I = 33 * MiB, WS_W2O = 44 * MiB;
constexpr size_t WS_XN = 50 * MiB, WS_QKV = 114 * MiB, WS_ZG = 162 * MiB, WS_GATE = 226 * MiB, WS_ACT = 114 * MiB, WS_MIXED = 162 * MiB, WS_CAT = 354 * MiB, WS_Y = 354 * MiB, WS_END = 482 * MiB;
static_assert(WS_W1I + (size_t)NFI * D * 2 <= WS_W1O && WS_W1O + (size_t)D * DFF * 2 <= WS_WIN && WS_WIN + (size_t)INW * D * 2 <= WS_WBR && WS_W2I + (size_t)NFI * D * 2 <= WS_W2O && WS_W2O + (size_t)D * DFF * 2 <= WS_XN, "weights map");
static_assert(WS_XN + (size_t)M * D * 2 <= WS_QKV && WS_QKV + (size_t)M * 768 * 2 <= WS_ZG && WS_ZG + (size_t)M * 1024 * 2 <= WS_GATE && WS_GATE + (size_t)M * 2048 * 2 <= WS_CAT && WS_ACT + (size_t)M * DFF * 2 <= WS_CAT && WS_Y + (size_t)M * D * 4 <= WS_END, "activation map");
constexpr int CW_TMO = 0, CW_CODE = 1, CW_BAR = 4096;
constexpr int RING_OFF = 0, RING_BYTES = 131072, LDSCTL_OFF = RING_BYTES, MISC_OFF = LDSCTL_OFF + 320, LDS_BYTES = 147456;

#define GAS __attribute__((address_space(1)))
#define LAS __attribute__((address_space(3)))
typedef unsigned short bf16;
typedef unsigned v4u __attribute__((ext_vector_type(4)));
typedef float f32x4 __attribute__((ext_vector_type(4)));
typedef short bf16x8 __attribute__((ext_vector_type(8)));
typedef GAS unsigned gu32;
typedef GAS unsigned long long gu64;
#define RLX_AGENT __ATOMIC_RELAXED, __HIP_MEMORY_SCOPE_AGENT
#define LDS_WAIT() asm volatile("s_waitcnt lgkmcnt(0)" ::: "memory")
#define VM_WAIT() asm volatile("s_waitcnt vmcnt(0)" ::: "memory")
__device__ __forceinline__ unsigned long long rt() { return __builtin_amdgcn_s_memrealtime(); }
__device__ __forceinline__ unsigned f2bf(float f) { unsigned u = __builtin_bit_cast(unsigned, f); return (u + 0x7fffu + ((u >> 16) & 1u)) >> 16; }
__device__ __forceinline__ unsigned pk2(float lo, float hi) { return f2bf(lo) | (f2bf(hi) << 16); }

#define XB_TMO      128
#define XB_XCNT(j)  (256  + 64 * (j))
#define XB_XSUB(j)  (1280 + 64 * (j))
#define XB_XGEN(j)  (2304 + 64 * (j))
#define XB_TOP      3328
#define XB_TOPGEN   3392
#define XCD_BAR_WORDS 3456
#define XB_SPIN_CAP (1u << 18)

__device__ __forceinline__ unsigned xb_ld(unsigned* p)              { return __hip_atomic_load(p, __ATOMIC_RELAXED, __HIP_MEMORY_SCOPE_AGENT); }
__device__ __forceinline__ unsigned xb_add(unsigned* p, unsigned v) { return __hip_atomic_fetch_add(p, v, __ATOMIC_RELAXED, __HIP_MEMORY_SCOPE_AGENT); }
__device__ __forceinline__ unsigned xb_xcc_id() { return (unsigned)__builtin_amdgcn_s_getreg((3 << 11) | 20) & 0xFu; }
#define XB_SPIN(cond, bar) do { unsigned _sp = 0; while (cond) { __builtin_amdgcn_s_sleep(1); \
    if ((++_sp & 255u) == 0u) { if (xb_ld(&(bar)[XB_TMO])) break; if (_sp > XB_SPIN_CAP) { atomicAdd(&(bar)[XB_TMO], 1u); break; } } } } while (0)

struct XcdBarrier {
    unsigned* bar; unsigned x;
    volatile LAS unsigned* st;
};

__device__ __forceinline__ XcdBarrier xcd_barrier_post(unsigned* bar, volatile LAS unsigned* st) {
    XcdBarrier b; b.bar = bar; b.x = xb_xcc_id(); b.st = st;
    if (threadIdx.x == 0) (void)xb_add(&bar[XB_XCNT(b.x)], 1u);
    return b;
}
__device__ __forceinline__ void xcd_barrier_complete(unsigned* bar, unsigned x, unsigned& nloc, unsigned& nx) {
    const unsigned G = gridDim.x * gridDim.y * gridDim.z;
    unsigned sum, cnt, mine, sp = 0u;
    for (;;) {
        sum = 0u; cnt = 0u; mine = 0u;
#pragma unroll
        for (unsigned j = 0; j < 16; ++j) { const unsigned c = xb_ld(&bar[XB_XCNT(j)]); sum += c; cnt += (c > 0u) ? 1u : 0u; mine = (j == x) ? c : mine; }
        if (sum == G) break;
        __builtin_amdgcn_s_sleep(1);
        if ((++sp & 255u) == 0u) { if (xb_ld(&bar[XB_TMO])) break; if (sp > XB_SPIN_CAP) { atomicAdd(&bar[XB_TMO], 1u); break; } }
    }
    nloc = mine > 0u ? mine : 1u; nx = cnt > 0u ? cnt : 1u;
}

__device__ __forceinline__ void xcd_barrier(const XcdBarrier& b) {
    asm volatile("s_waitcnt vmcnt(0)" ::: "memory");
    __syncthreads();
    if (threadIdx.x == 0) {
        unsigned* bar = b.bar;
        __builtin_amdgcn_s_waitcnt(0);
        unsigned nloc = b.st[0], nx = b.st[1];
        if (nloc == 0u) { xcd_barrier_complete(bar, b.x, nloc, nx); b.st[0] = nloc; b.st[1] = nx; }
        const unsigned old = xb_add(&bar[XB_XSUB(b.x)], 1u);
        const unsigned gen = old / nloc;
        if (old + 1u == (gen + 1u) * nloc) {
            __builtin_amdgcn_fence(__ATOMIC_RELEASE, "agent");
            asm volatile("s_waitcnt vmcnt(0)" ::: "memory");
            const unsigned og = xb_add(&bar[XB_TOP], 1u);
            const unsigned tg = og / nx;
            if (og + 1u == (tg + 1u) * nx) xb_add(&bar[XB_TOPGEN], 1u);
            else XB_SPIN(xb_ld(&bar[XB_TOPGEN]) == tg, bar);
            __builtin_amdgcn_fence(__ATOMIC_ACQUIRE, "agent");
            xb_add(&bar[XB_XGEN(b.x)], 1u);
            asm volatile("s_waitcnt vmcnt(0)" ::: "memory");
        } else {
            XB_SPIN(xb_ld(&bar[XB_XGEN(b.x)]) == gen, bar);
            __builtin_amdgcn_fence(__ATOMIC_ACQUIRE, "agent");
            asm volatile("s_waitcnt vmcnt(0)" ::: "memory");
        }
    }
    __syncthreads();
}

__device__ __forceinline__ float wave_sum(float v) {
#pragma unroll
    for (int o = 1; o < 64; o <<= 1) v += __shfl_xor(v, o);
    return v;
}
__device__ __forceinline__ float wave_max(float v) {
#pragma unroll
    for (int o = 1; o < 64; o <<= 1) v = fmaxf(v, __shfl_xor(v, o));
    return v;
}
__device__ __forceinline__ float bf2f(bf16 h) { return __uint_as_float((unsigned)h << 16); }
__device__ __forceinline__ float bflo(unsigned w) { return __uint_as_float(w << 16); }
__device__ __forceinline__ float bfhi(unsigned w) { return __uint_as_float(w & 0xffff0000u); }

struct Args { const float* in[20]; float* out; unsigned char* ws; int ph_lo, ph_hi; };

__device__ __forceinline__ void tr_item(const float* W, int N, bf16* WT, int ldk, int kdst0, int drow0, int k0, int n0, LAS float* scr, int lane) {
#pragma unroll 8
    for (int i = 0; i < 32; ++i) { const int kk = 2 * i + (lane >> 5); scr[kk * 33 + (lane & 31)] = W[(size_t)(k0 + kk) * N + n0 + (lane & 31)]; }
    LDS_WAIT(); asm volatile("" ::: "memory");
    const int c = lane & 7;
#pragma unroll
    for (int j = 0; j < 4; ++j) { const int n = (lane >> 3) + 8 * j; const LAS float* s = scr + (8 * c) * 33 + n;
        v4u o; o.x = pk2(s[0 * 33], s[1 * 33]); o.y = pk2(s[2 * 33], s[3 * 33]); o.z = pk2(s[4 * 33], s[5 * 33]); o.w = pk2(s[6 * 33], s[7 * 33]);
        *(GAS v4u*)(WT + (size_t)(drow0 + n) * ldk + kdst0 + k0 + 8 * c) = o; }
    LDS_WAIT(); asm volatile("" ::: "memory");
}
__device__ __forceinline__ void tr_matrix(const float* W, int K, int N, bf16* WT, int ldk, int kdst0, bool ffnmap, int r, LAS float* scr, int lane) {
    const int nblk = N / 32, kb = r / nblk, nb = r % nblk, n0 = 32 * nb;
    int drow0 = n0;
    if (ffnmap) { const int up = n0 >= DFF, j = up ? n0 - DFF : n0; drow0 = 256 * (j >> 7) + (up ? 128 : 0) + (j & 127); }
    tr_item(W, N, WT, ldk, kdst0, drow0, 64 * kb, n0, scr, lane);
}

__device__ __forceinline__ void phase_p0a(const Args& a, LAS unsigned char* lds, int tid, int lane, int wave, int vcu, int G) {
    unsigned char* ws = a.ws;
    float* ADA = (float*)(ws + WS_ADA);
    LAS float* scT = (LAS float*)(lds + 98304);
    LAS float* red = (LAS float*)(lds + 114688);
    for (int i = tid; i < BATCH * D; i += NTHREADS) { const float v = a.in[1][i]; scT[i] = v / (1.f + __expf(-v)); }
    __syncthreads();
    for (int item = blockIdx.x; item < NADA / 64; item += G) {
        const float* w = a.in[3] + (size_t)(wave * 128) * NADA + item * 64 + lane;
        float a0 = 0.f, a1 = 0.f, a2 = 0.f, a3 = 0.f;
#pragma unroll 16
        for (int k = 0; k < 128; ++k) { const float wv = w[(size_t)k * NADA]; const int kk = wave * 128 + k;
            a0 += scT[kk] * wv; a1 += scT[1024 + kk] * wv; a2 += scT[2048 + kk] * wv; a3 += scT[3072 + kk] * wv; }
        red[(wave * 4 + 0) * 64 + lane] = a0; red[(wave * 4 + 1) * 64 + lane] = a1; red[(wave * 4 + 2) * 64 + lane] = a2; red[(wave * 4 + 3) * 64 + lane] = a3;
        __syncthreads();
        if (wave < 4) { float s = a.in[4][item * 64 + lane];
#pragma unroll
            for (int w8 = 0; w8 < 8; ++w8) s += red[(w8 * 4 + wave) * 64 + lane];
            ADA[wave * NADA + item * 64 + lane] = s; }
        __syncthreads();
    }
    { const int gt = blockIdx.x * NTHREADS + tid;
        bf16* WSM = (bf16*)(ws + WS_WSM);
        for (int i = gt; i < 8 * 128 * 128; i += G * NTHREADS) { const int s = i & 127, t = (i >> 7) & 127; WSM[i] = (s <= t) ? (bf16)f2bf(a.in[13][i]) : (bf16)0; } }
    LAS float* scr = (LAS float*)(lds + wave * 12288);
    const int gw = vcu * NWAVES + wave, NGW = G * NWAVES;
    constexpr int I_FI = (D / 64) * (NFI / 32), I_FO = (DFF / 64) * (D / 32), I_IN = (D / 64) * (INW / 32), I_BR = (512 / 64) * (D / 32), I_O = (D / 64) * (D / 32);
    constexpr int NITEMS = 2 * I_FI + 2 * I_FO + I_IN + 2 * I_BR + I_O;
    for (int it = gw; it < NITEMS; it += NGW) {
        int r = it;
        if (r < I_FI) { tr_matrix(a.in[7], D, NFI, (bf16*)(ws + WS_W1I), D, 0, true, r, scr, lane); continue; } r -= I_FI;
        if (r < I_FI) { tr_matrix(a.in[18], D, NFI, (bf16*)(ws + WS_W2I), D, 0, true, r, scr, lane); continue; } r -= I_FI;
        if (r < I_FO) { tr_matrix(a.in[8], DFF, D, (bf16*)(ws + WS_W1O), DFF, 0, false, r, scr, lane); continue; } r -= I_FO;
        if (r < I_FO) { tr_matrix(a.in[19], DFF, D, (bf16*)(ws + WS_W2O), DFF, 0, false, r, scr, lane); continue; } r -= I_FO;
        if (r < I_IN) { tr_matrix(a.in[9], D, INW, (bf16*)(ws + WS_WIN), D, 0, false, r, scr, lane); continue; } r -= I_IN;
        if (r < I_BR) { tr_matrix(a.in[15], 512, D, (bf16*)(ws + WS_WBR), D, 0, false, r, scr, lane); continue; } r -= I_BR;
        if (r < I_BR) { tr_matrix(a.in[16], 512, D, (bf16*)(ws + WS_WBR), D, 512, false, r, scr, lane); continue; } r -= I_BR;
        tr_matrix(a.in[17], D, D, (bf16*)(ws + WS_WOUT), D, 0, false, r, scr, lane);
    }
}

__device__ __forceinline__ void phase_p0b(const Args& a, int tid, int lane, int wave, int vcu, int G) {
    unsigned char* ws = a.ws;
    const float* ADA = (const float*)(ws + WS_ADA); float* DV = (float*)(ws + WS_DV); bf16* XN = (bf16*)(ws + WS_XN);
    for (int idx = blockIdx.x * NTHREADS + tid; idx < 36 * 1024; idx += G * NTHREADS) {
        const int col = idx & 1023, q = idx >> 10, kind = q % 3, sb = q / 3, s = sb >> 2, b = sb & 3;
        const float* ad = ADA + b * NADA + 3 * s * 1024;
        float v;
        if (kind == 0) v = a.in[5][s * 1024 + col] * (1.f + ad[1024 + col]);
        else if (kind == 1) v = ad[col];
        else v = (s == 1 ? 1.f : 0.5f) * ad[2048 + col] * a.in[6][s * 1024 + col];
        DV[idx] = v;
    }
    const int gw = vcu * NWAVES + wave, NGW = G * NWAVES;
    for (int m = gw; m < M; m += NGW) {
        const int b = m >> 13;
        const GAS f32x4* xr = (const GAS f32x4*)(a.in[0] + (size_t)m * D) + lane;
        f32x4 v[4]; float s = 0.f;
#pragma unroll
        for (int j = 0; j < 4; ++j) { v[j] = xr[64 * j]; s += (v[j].x * v[j].x + v[j].y * v[j].y) + (v[j].z * v[j].z + v[j].w * v[j].w); }
        const float rstd = 1.f / sqrtf(wave_sum(s) * (1.f / D) + EPS);
        GAS unsigned long long* o8 = (GAS unsigned long long*)(XN + (size_t)m * D) + lane;
#pragma unroll
        for (int j = 0; j < 4; ++j) { const int col = 4 * lane + 256 * j;
            const f32x4 g = *(const f32x4*)(a.in[5] + col), sc = *(const f32x4*)(ADA + b * NADA + 1024 + col), sh = *(const f32x4*)(ADA + b * NADA + col);
            const f32x4 o = v[j] * rstd * (g * (1.f + sc)) + sh;
            o8[64 * j] = (unsigned long long)pk2(o.x, o.y) | ((unsigned long long)pk2(o.z, o.w) << 32); }
    }
}

__device__ __forceinline__ void phase_rownorm(const Args& a, int s, const float* base, bool has_next, int lane, int wave, int vcu, int G) {
    unsigned char* ws = a.ws;
    const float* DV = (const float*)(ws + WS_DV); const float* Y = (const float*)(ws + WS_Y); bf16* XN = (bf16*)(ws + WS_XN);
    const int gw = vcu * NWAVES + wave, NGW = G * NWAVES;
    for (int m = gw; m < M; m += NGW) {
        const int b = m >> 13;
        const float* dv = DV + (size_t)((s * 4 + b) * 3) * 1024;
        const GAS f32x4* yr = (const GAS f32x4*)(Y + (size_t)m * D) + lane;
        const GAS f32x4* br = (const GAS f32x4*)(base + (size_t)m * D) + lane;
        GAS f32x4* orow = (GAS f32x4*)(a.out + (size_t)m * D) + lane;
        f32x4 y[4], h[4]; float sq = 0.f;
#pragma unroll
        for (int j = 0; j < 4; ++j) { y[j] = yr[64 * j]; h[j] = br[64 * j]; sq += (y[j].x * y[j].x + y[j].y * y[j].y) + (y[j].z * y[j].z + y[j].w * y[j].w); }
        const float rstd = 1.f / sqrtf(wave_sum(sq) * (1.f / D) + EPS);
        float sq2 = 0.f;
#pragma unroll
        for (int j = 0; j < 4; ++j) { const f32x4 g = *(const f32x4*)(dv + 2048 + 4 * lane + 256 * j);
            h[j] = h[j] + g * y[j] * rstd; orow[64 * j] = h[j];
            sq2 += (h[j].x * h[j].x + h[j].y * h[j].y) + (h[j].z * h[j].z + h[j].w * h[j].w); }
        if (has_next) {
            const float* dn = DV + (size_t)(((s + 1) * 4 + b) * 3) * 1024;
            const float rstd2 = 1.f / sqrtf(wave_sum(sq2) * (1.f / D) + EPS);
            GAS unsigned long long* o8 = (GAS unsigned long long*)(XN + (size_t)m * D) + lane;
#pragma unroll
            for (int j = 0; j < 4; ++j) { const int col = 4 * lane + 256 * j;
                const f32x4 A = *(const f32x4*)(dn + col), sh = *(const f32x4*)(dn + 1024 + col);
                const f32x4 o = h[j] * rstd2 * A + sh;
                o8[64 * j] = (unsigned long long)pk2(o.x, o.y) | ((unsigned long long)pk2(o.z, o.w) << 32); }
        }
    }
}

__device__ __forceinline__ void phase_mix_simple(const Args& a, LAS unsigned char* lds, int tid, int lane, int wave, int vcu, int G) {
    unsigned char* ws = a.ws;
    const bf16* QKV = (const bf16*)(ws + WS_QKV); const bf16* ZG = (const bf16*)(ws + WS_ZG); bf16* CAT = (bf16*)(ws + WS_CAT);
    for (int unit = vcu; unit < 256; unit += G) {
        const int b = unit >> 6, ci = unit & 63; const size_t r0 = (size_t)b * SEQ + (size_t)ci * 128;
        LAS float* biasT = (LAS float*)lds;
        LAS float* qs = (LAS float*)(lds + 4096) + wave * 64;
        LAS float* ps = (LAS float*)(lds + 4096 + 2048) + wave * 128;
        for (int i = tid; i < 1024; i += NTHREADS) { const int h = i >> 7, d = i & 127;
            int bk = d; if (d >= 16) { bk = 16 + (int)(logf((float)d * (1.f / 16.f)) / logf(8.f) * 16.f); bk = bk > 31 ? 31 : bk; }
            biasT[i] = a.in[2][bk * 8 + h]; }
        __syncthreads();
        {   const int h = wave, kvh = h >> 2; const float sink = a.in[10][h];
            for (int tl = 0; tl < 128; ++tl) {
                const size_t row = r0 + tl;
                qs[lane] = bf2f(QKV[row * 768 + h * 64 + lane]);
                asm volatile("s_waitcnt lgkmcnt(0)" ::: "memory");
                float sc[2];
#pragma unroll
                for (int e = 0; e < 2; ++e) { const int dist = lane + 64 * e; const int kp = ci * 128 + tl - dist; const bool valid = kp >= 0;
                    const bf16* kptr = QKV + ((size_t)b * SEQ + (valid ? kp : 0)) * 768 + 512 + kvh * 64;
                    float acc = 0.f;
#pragma unroll
                    for (int c8 = 0; c8 < 8; ++c8) { const v4u kv = *(const GAS v4u*)(kptr + 8 * c8);
                        const f32x4 q0 = *(const LAS f32x4*)(qs + 8 * c8), q1 = *(const LAS f32x4*)(qs + 8 * c8 + 4);
                        acc += bflo(kv.x) * q0.x + bfhi(kv.x) * q0.y + bflo(kv.y) * q0.z + bfhi(kv.y) * q0.w + bflo(kv.z) * q1.x + bfhi(kv.z) * q1.y + bflo(kv.w) * q1.z + bfhi(kv.w) * q1.w; }
                    sc[e] = valid ? acc + biasT[h * 128 + dist] : -1e30f; }
                const float mx = fmaxf(wave_max(fmaxf(sc[0], sc[1])), sink);
                const float p0 = __expf(sc[0] - mx), p1 = __expf(sc[1] - mx);
                const float denom = wave_sum(p0 + p1) + __expf(sink - mx);
                ps[lane] = p0; ps[lane + 64] = p1;
                asm volatile("s_waitcnt lgkmcnt(0)" ::: "memory");
                float o = 0.f;
                const int nk = min(128, ci * 128 + tl + 1);
                const bf16* vptr = QKV + ((size_t)b * SEQ + ci * 128 + tl) * 768 + 640 + kvh * 64 + lane;
#pragma unroll 8
                for (int dist = 0; dist < nk; ++dist) o += ps[dist] * bf2f(vptr[-(ptrdiff_t)dist * 768]);
                CAT[row * 1024 + h * 64 + lane] = (bf16)f2bf(o / denom);
                asm volatile("s_waitcnt lgkmcnt(0)" ::: "memory");
            }
        }
        __syncthreads();
        LAS bf16* vn = (LAS bf16*)lds;
        for (int tl = wave * 16; tl < wave * 16 + 16; ++tl) {
            const v4u raw = *(const GAS v4u*)(ZG + (r0 + tl) * 1024 + 512 + 8 * lane);
            float x[8] = {bflo(raw.x), bfhi(raw.x), bflo(raw.y), bfhi(raw.y), bflo(raw.z), bfhi(raw.z), bflo(raw.w), bfhi(raw.w)};
            float s = 0.f;
#pragma unroll
            for (int e = 0; e < 8; ++e) s += x[e];
            const float mu = wave_sum(s) * (1.f / 512.f); float q = 0.f;
#pragma unroll
            for (int e = 0; e < 8; ++e) { x[e] -= mu; q += x[e] * x[e]; }
            const float rstd = 1.f / sqrtf(wave_sum(q) * (1.f / 512.f) + EPS);
            const f32x4 g0 = *(const f32x4*)(a.in[11] + 8 * lane), g1 = *(const f32x4*)(a.in[11] + 8 * lane + 4), b0 = *(const f32x4*)(a.in[12] + 8 * lane), b1 = *(const f32x4*)(a.in[12] + 8 * lane + 4);
            v4u o; o.x = pk2(x[0] * rstd * g0.x + b0.x, x[1] * rstd * g0.y + b0.y); o.y = pk2(x[2] * rstd * g0.z + b0.z, x[3] * rstd * g0.w + b0.w);
            o.z = pk2(x[4] * rstd * g1.x + b1.x, x[5] * rstd * g1.y + b1.y); o.w = pk2(x[6] * rstd * g1.z + b1.z, x[7] * rstd * g1.w + b1.w);
            *(LAS v4u*)(vn + tl * 512 + 8 * lane) = o;
        }
        __syncthreads();
        {   const int ch = tid, g = wave;
            for (int tl = 0; tl < 128; ++tl) {
                const float* wrow = a.in[13] + (size_t)(g * 128 + tl) * 128;
                float acc = 0.f;
                for (int s = 0; s <= tl; ++s) acc += wrow[s] * bf2f(vn[s * 512 + ch]);
                const float sp = acc + a.in[14][g * 128 + tl];
                const float uu = bf2f(ZG[(r0 + tl) * 1024 + ch]);
                CAT[(r0 + tl) * 1024 + 512 + ch] = (bf16)f2bf(uu * sp);
            }
        }
        __syncthreads();
    }
}


__global__ void __launch_bounds__(NTHREADS, 2) fwd_kernel(Args args) {
    extern __shared__ __attribute__((aligned(16))) unsigned char lds_raw[];
    LAS unsigned char* lds = (LAS unsigned char*)lds_raw;
    volatile LAS unsigned* MISC = (volatile LAS unsigned*)(lds + MISC_OFF);
    const int tid = threadIdx.x, lane = tid & 63, wave = __builtin_amdgcn_readfirstlane(tid >> 6);
    const int G = gridDim.x; const int bx = blockIdx.x; const int vcu = (G % 8 == 0) ? (bx % 8) * (G / 8) + bx / 8 : bx;
    unsigned char* ws = args.ws;
    gu32* ctl = (gu32*)(ws + WS_CTL);
    for (int u = tid; u < (LDS_BYTES - LDSCTL_OFF) / 4; u += NTHREADS) ((LAS unsigned*)(lds + LDSCTL_OFF))[u] = 0u;
    __syncthreads();
    XcdBarrier bar; bar.bar = (unsigned*)(ctl + CW_BAR); bar.x = 0; bar.st = nullptr;
    if (N_LAUNCHES == 1) bar = xcd_barrier_post((unsigned*)(ctl + CW_BAR), MISC + 8);
    const int lo = args.ph_lo, hi = args.ph_hi;
#define IN(k) (lo <= (k) && (k) < hi)
#define SEAM(k) do { if (IN(k) && IN((k) + 1)) xcd_barrier(bar); } while (0)
    bf16* XN = (bf16*)(ws + WS_XN); bf16* ACT = (bf16*)(ws + WS_ACT); float* Y = (float*)(ws + WS_Y);
    bf16* QKVb = (bf16*)(ws + WS_QKV); bf16* ZGb = (bf16*)(ws + WS_ZG); bf16* GATEb = (bf16*)(ws + WS_GATE); bf16* CATb = (bf16*)(ws + WS_CAT); bf16* MIXb = (bf16*)(ws + WS_MIXED);

    if (IN(0)) { phase_p0a(args, lds, tid, lane, wave, vcu, G); } SEAM(0);
    if (IN(1)) { phase_p0b(args, tid, lane, wave, vcu, G); } SEAM(1);
    if (IN(2)) {
        pg8::Gemm g{XN, (const bf16*)(ws + WS_W1I), M, NFI, D, D, D, 0}; pg8::StaticOrder S; S.init(M, NFI, G, bx);
        pg8::EpiSwiglu E{ACT, DFF};
        pg8::gemm_phase<pg8::EpiSwiglu, pg8::StaticOrder, true, true>(lds + RING_OFF, g, S, E);
    } SEAM(2);
    if (IN(3)) {
        pg8::Gemm g{ACT, (const bf16*)(ws + WS_W1O), M, D, DFF, DFF, DFF, 0}; pg8::StaticOrder S; S.init(M, D, G, bx);
        pg8::EpiF32 E{Y, D};
        pg8::gemm_phase<pg8::EpiF32, pg8::StaticOrder, true, true>(lds + RING_OFF, g, S, E);
    } SEAM(3);
    if (IN(4)) { phase_rownorm(args, 0, args.in[0], true, lane, wave, vcu, G); } SEAM(4);
    if (IN(5)) {
        pg8::Gemm g{XN, (const bf16*)(ws + WS_WIN), M, INW, D, D, D, 0}; pg8::StaticOrder S; S.init(M, INW, G, bx);
        pg8::EpiZ E{QKVb, ZGb, GATEb};
        pg8::gemm_phase<pg8::EpiZ, pg8::StaticOrder, true, true>(lds + RING_OFF, g, S, E);
    } SEAM(5);
    if (IN(6)) { phase_mix_simple(args, lds, tid, lane, wave, vcu, G); } SEAM(6);
    if (IN(7)) {
        pg8::Gemm g{CATb, (const bf16*)(ws + WS_WBR), M, D, 512, D, D, 1024}; pg8::SegOrder S; S.S.init(M, D, G, bx);
        pg8::EpiBr E{GATEb, MIXb};
        pg8::gemm_phase<pg8::EpiBr, pg8::SegOrder, true, true>(lds + RING_OFF, g, S, E);
    } SEAM(7);
    if (IN(8)) {
        pg8::Gemm g{MIXb, (const bf16*)(ws + WS_WOUT), M, D, D, D, D, 0}; pg8::StaticOrder S; S.init(M, D, G, bx);
        pg8::EpiF32 E{Y, D};
        pg8::gemm_phase<pg8::EpiF32, pg8::StaticOrder, true, true>(lds + RING_OFF, g, S, E);
    } SEAM(8);
    if (IN(9)) { phase_rownorm(args, 1, args.out, true, lane, wave, vcu, G); } SEAM(9);
    if (IN(10)) {
        pg8::Gemm g{XN, (const bf16*)(ws + WS_W2I), M, NFI, D, D, D, 0}; pg8::StaticOrder S; S.init(M, NFI, G, bx);
        pg8::EpiSwiglu E{ACT, DFF};
        pg8::gemm_phase<pg8::EpiSwiglu, pg8::StaticOrder, true, true>(lds + RING_OFF, g, S, E);
    } SEAM(10);
    if (IN(11)) {
        pg8::Gemm g{ACT, (const bf16*)(ws + WS_W2O), M, D, DFF, DFF, DFF, 0}; pg8::StaticOrder S; S.init(M, D, G, bx);
        pg8::EpiF32 E{Y, D};
        pg8::gemm_phase<pg8::EpiF32, pg8::StaticOrder, true, true>(lds + RING_OFF, g, S, E);
    } SEAM(11);
    if (IN(12)) { phase_rownorm(args, 2, args.out, false, lane, wave, vcu, G); }
#undef IN
#undef SEAM
}

#if DBG_DUMP
__global__ void dbg_dump(const unsigned short* buf, int ld, int coff, float* out) {
    const size_t i = (size_t)blockIdx.x * blockDim.x + threadIdx.x; const size_t m = i >> 10; const int c = (int)(i & 1023);
    out[i] = __uint_as_float((unsigned)buf[m * ld + coff + c] << 16);
}
#endif
extern "C" void kernel_launch(void* const* d_in, const int* in_sizes, int n_in, void* d_out, int out_size, void* d_ws, size_t ws_size, hipStream_t stream) {
    static int grid = 0;
    if (grid == 0) {
        if (n_in != 20 || in_sizes[0] != M * D || out_size != M * D || ws_size < WS_END) { fprintf(stderr, "kernel_launch: unexpected shapes (n_in %d, in0 %d, out %d, ws %zu); nothing launched\n", n_in, n_in > 0 ? in_sizes[0] : -1, out_size, ws_size); grid = -1; return; }
        int dev = 0, cus = 0, per_cu = 0;
        if (hipGetDevice(&dev) != hipSuccess || hipDeviceGetAttribute(&cus, hipDeviceAttributeMultiprocessorCount, dev) != hipSuccess) { fprintf(stderr, "kernel_launch: device query failed\n"); grid = -1; return; }
        if (hipFuncSetAttribute((const void*)fwd_kernel, hipFuncAttributeMaxDynamicSharedMemorySize, LDS_BYTES) != hipSuccess) { fprintf(stderr, "kernel_launch: hipFuncSetAttribute failed\n"); grid = -1; return; }
        if (hipOccupancyMaxActiveBlocksPerMultiprocessor(&per_cu, (const void*)fwd_kernel, NTHREADS, LDS_BYTES) != hipSuccess || per_cu < 1)
            fprintf(stderr, "kernel_launch: note: occupancy query reports %d workgroups per CU\n", per_cu);
        (void)hipGetLastError();
        grid = cus;
    }
    if (grid < 0) return;
    if (hipMemsetAsync((char*)d_ws + WS_CTL, 0, CTL_ZERO_BYTES, stream) != hipSuccess) { fprintf(stderr, "kernel_launch: memset failed\n"); return; }
    Args a{};
    for (int i = 0; i < 20; ++i) a.in[i] = (const float*)d_in[i];
    a.out = (float*)d_out; a.ws = (unsigned char*)d_ws;
    for (int li = 0; li < N_LAUNCHES; ++li) {
        a.ph_lo = (N_LAUNCHES == 1) ? 0 : li; a.ph_hi = (N_LAUNCHES == 1) ? DBG_STOP : li + 1; if (li >= DBG_STOP) break;
        hipLaunchKernelGGL(fwd_kernel, dim3(grid), dim3(NTHREADS), LDS_BYTES, stream, a);
        const hipError_t le = hipPeekAtLastError();
        if (le != hipSuccess) { fprintf(stderr, "kernel_launch: launch %d failed: %s\n", li, hipGetErrorName(le)); break; }
    }
#if DBG_DUMP == 1
    hipLaunchKernelGGL(dbg_dump, dim3(M * D / 256), dim3(256), 0, stream, (const unsigned short*)((char*)d_ws + WS_XN), 1024, 0, (float*)d_out);
#elif DBG_DUMP == 3
    hipLaunchKernelGGL(dbg_dump, dim3(M * D / 256), dim3(256), 0, stream, (const unsigned short*)((char*)d_ws + WS_CAT), 1024, 0, (float*)d_out);
#elif DBG_DUMP == 4
    hipLaunchKernelGGL(dbg_dump, dim3(M * D / 256), dim3(256), 0, stream, (const unsigned short*)((char*)d_ws + WS_MIXED), 1024, 0, (float*)d_out);
#elif DBG_DUMP == 6
    hipLaunchKernelGGL(dbg_dump, dim3(M * D / 256), dim3(256), 0, stream, (const unsigned short*)((char*)d_ws + WS_ZG), 1024, 0, (float*)d_out);
#elif DBG_DUMP == 8
    hipLaunchKernelGGL(dbg_dump, dim3(M * D / 256), dim3(256), 0, stream, (const unsigned short*)((char*)d_ws + WS_GATE), 2048, 0, (float*)d_out);
#elif DBG_DUMP == 7
    hipLaunchKernelGGL(dbg_dump, dim3(M * D / 256), dim3(256), 0, stream, (const unsigned short*)((char*)d_ws + WS_GATE), 2048, 1024, (float*)d_out);
#elif DBG_DUMP == 2
    hipLaunchKernelGGL(dbg_dump, dim3(M * D / 256), dim3(256), 0, stream, (const unsigned short*)((char*)d_ws + WS_ACT), DFF, 0, (float*)d_out);
#endif
}
```

```cpp
#include <hip/hip_runtime.h>
#include <cstdio>
#include <cstdint>


namespace pg8 {
#define PG8_LAS __attribute__((address_space(3)))
typedef unsigned short bf16_t;
typedef short bf16x8 __attribute__((ext_vector_type(8)));
typedef float f32x4 __attribute__((ext_vector_type(4)));
typedef unsigned u32x4 __attribute__((ext_vector_type(4)));
constexpr int BM = 256, BK = 64, HALF = 128, HTB = HALF * BK * 2  , STAGE_BYTES = 8 * HTB, NXCD = 8, WGM = 8;

__host__ __device__ __forceinline__ int lds_byte(int r, int c) { const int st = (r >> 4) * 2 + (c >> 5), rr = r & 15, cc = c & 31, ob = rr * 64 + cc * 2; return st * 1024 + (ob ^ (((ob >> 9) & 1) << 5)); }
__host__ __device__ __forceinline__ void stage_rc(int b, int& R, int& C) { const int st = b / 1024, sb = b % 1024, swz = sb ^ (((sb >> 9) & 1) << 5); R = (st >> 1) * 16 + swz / 64; C = (st & 1) * 32 + (swz % 64) / 2; }
__host__ __device__ __forceinline__ int perm32(int rho) { const int n = rho >> 4, i = rho & 15; return 8 * (i >> 2) + 4 * n + (i & 3); }

struct Unit { int pm, pn, seg; };
struct Gemm { const bf16_t* A; const bf16_t* Bt; int M, N, K, lda, ldb, segoff; };

struct StaticOrder {
    int nM, nN, nwg, G, c;
    __host__ __device__ void init(int M, int N, int G_, int c_) { nM = M / BM; nN = N / BM; nwg = nM * nN; G = G_; c = c_; }
    __host__ __device__ bool next(int i, Unit& u) const {
        const long L = (long)i * G + c; if (L >= nwg) return false;
        int wgid = (int)L; { const int q = nwg / NXCD, r = nwg % NXCD, xcd = wgid % NXCD, off = wgid / NXCD; wgid = (xcd < r ? xcd * (q + 1) : r * (q + 1) + (xcd - r) * q) + off; }
        const int nig = WGM * nN, gid = wgid / nig, fm = gid * WGM, gsz = (nM - fm) < WGM ? (nM - fm) : WGM;
        u.pm = fm + ((wgid % nig) % gsz); u.pn = (wgid % nig) / gsz; u.seg = 0; return true;
    }
    __device__ __forceinline__ void a_ready(const Unit&) const {}
    __device__ __forceinline__ void done(const Unit&) const {}
};
typedef float f32x2_cv __attribute__((ext_vector_type(2))); typedef __bf16 bf16x2_cv __attribute__((ext_vector_type(2)));
__device__ __forceinline__ unsigned cvt_pk_bf16(float lo, float hi) { f32x2_cv v = {lo, hi}; bf16x2_cv b = __builtin_convertvector(v, bf16x2_cv); return __builtin_bit_cast(unsigned, b); }
typedef float f32x2 __attribute__((ext_vector_type(2)));
__device__ __forceinline__ float bf_lo(unsigned w) { return __uint_as_float(w << 16); }
__device__ __forceinline__ float bf_hi(unsigned w) { return __uint_as_float(w & 0xffff0000u); }
__device__ __forceinline__ float sigm(float x) { return __builtin_amdgcn_rcpf(1.f + __builtin_amdgcn_exp2f(-1.4426950408889634f * x)); }
__device__ __forceinline__ float gelu_t(float x) { const float u2 = 1.5957691216057308f * (x + 0.044715f * x * x * x); return x * sigm(u2); }
__device__ __forceinline__ u32x4 pack8(const f32x4& a, const f32x4& b) { u32x4 w; w.x = cvt_pk_bf16(a[0], a[1]); w.y = cvt_pk_bf16(a[2], a[3]); w.z = cvt_pk_bf16(b[0], b[1]); w.w = cvt_pk_bf16(b[2], b[3]); return w; }

struct EpiSwiglu {
    static constexpr bool PERM = true, AFTER_DRAIN = false;
    bf16_t* O; int ldc;
    __device__ __forceinline__ void operator()(f32x4 (&acc)[2][2][4][2], const Unit& u, int wr, int wc, int fr, int fq) const {
        const int row0 = u.pm * BM + wr * 64 + fr, col0 = u.pn * HALF + wc * 32 + 8 * fq;
#pragma unroll
        for (int ai = 0; ai < 2; ++ai)
#pragma unroll
            for (int m = 0; m < 4; ++m) {
                bf16_t* p = O + (size_t)(row0 + ai * HALF + m * 16) * ldc + col0;
                f32x4 v0, v1;
#pragma unroll
                for (int e = 0; e < 4; ++e) { const float g0 = acc[ai][0][m][0][e], g1 = acc[ai][0][m][1][e];
                    v0[e] = g0 * sigm(g0) * acc[ai][1][m][0][e]; v1[e] = g1 * sigm(g1) * acc[ai][1][m][1][e]; }
                *(u32x4*)p = pack8(v0, v1);
            }
    }
};
struct EpiZ {
    static constexpr bool PERM = true, AFTER_DRAIN = false;
    bf16_t *QKV, *ZG, *GATE;
    template <int KIND> __device__ __forceinline__ void tile(f32x4 (&acc)[2][2][4][2], bf16_t* base, int ldc, int row0, int col0) const {
#pragma unroll
        for (int ai = 0; ai < 2; ++ai)
#pragma unroll
            for (int m = 0; m < 4; ++m) {
                bf16_t* p = base + (size_t)(row0 + ai * HALF + m * 16) * ldc + col0;
#pragma unroll
                for (int bj = 0; bj < 2; ++bj) {
                    f32x4 v0 = acc[ai][bj][m][0], v1 = acc[ai][bj][m][1];
#pragma unroll
                    for (int e = 0; e < 4; ++e) {
                        if (KIND == 0) { v0[e] *= 0.125f; v1[e] *= 0.125f; }
                        if (KIND == 2) { v0[e] = gelu_t(v0[e]); v1[e] = gelu_t(v1[e]); }
                        if (KIND == 3) { v0[e] = sigm(v0[e]); v1[e] = sigm(v1[e]); }
                    }
                    *(u32x4*)(p + bj * HALF) = pack8(v0, v1);
                }
            }
    }
    __device__ __forceinline__ void operator()(f32x4 (&acc)[2][2][4][2], const Unit& u, int wr, int wc, int fr, int fq) const {
        const int pn = u.pn, row0 = u.pm * BM + wr * 64 + fr, cw = wc * 32 + 8 * fq;
        if (pn < 2) tile<0>(acc, QKV, 768, row0, pn * 256 + cw);
        else if (pn == 2) tile<1>(acc, QKV, 768, row0, 512 + cw);
        else if (pn < 7) tile<2>(acc, ZG, 1024, row0, (pn - 3) * 256 + cw);
        else tile<3>(acc, GATE, 2048, row0, (pn - 7) * 256 + cw);
    }
};
struct EpiF32 {
    static constexpr bool PERM = false, AFTER_DRAIN = false;
    float* O; int ldc;
    __device__ __forceinline__ void operator()(f32x4 (&acc)[2][2][4][2], const Unit& u, int wr, int wc, int fr, int fq) const {
        const int row0 = u.pm * BM + wr * 64 + fr, col0 = u.pn * BM + wc * 32 + 4 * fq;
#pragma unroll
        for (int ai = 0; ai < 2; ++ai)
#pragma unroll
            for (int m = 0; m < 4; ++m) { float* p = O + (size_t)(row0 + ai * HALF + m * 16) * ldc + col0;
#pragma unroll
                for (int bj = 0; bj < 2; ++bj)
#pragma unroll
                    for (int n = 0; n < 2; ++n) *(f32x4*)(p + bj * HALF + n * 16) = acc[ai][bj][m][n]; }
    }
};
struct EpiBr {
    static constexpr bool PERM = true, AFTER_DRAIN = false;
    const bf16_t* GATE; bf16_t* O;
    __device__ __forceinline__ void operator()(f32x4 (&acc)[2][2][4][2], const Unit& u, int wr, int wc, int fr, int fq) const {
        const int row0 = u.pm * BM + wr * 64 + fr, col0 = u.pn * BM + wc * 32 + 8 * fq;
        if (u.seg == 0) {
#if !defined(EXP_NOGATE)
#pragma unroll
            for (int ai = 0; ai < 2; ++ai)
#pragma unroll
                for (int m = 0; m < 4; ++m) { const bf16_t* gp = GATE + (size_t)(row0 + ai * HALF + m * 16) * 2048 + col0;
#pragma unroll
                    for (int bj = 0; bj < 2; ++bj) {
                        const u32x4 ga = *(const u32x4*)(gp + bj * HALF), gg = *(const u32x4*)(gp + 1024 + bj * HALF);
                        f32x4 r0, r1;
                        r0[0] = bf_lo(ga.x) * __builtin_amdgcn_rcpf(fmaxf(bf_lo(gg.x), 1e-30f)); r0[1] = bf_hi(ga.x) * __builtin_amdgcn_rcpf(fmaxf(bf_hi(gg.x), 1e-30f));
                        r0[2] = bf_lo(ga.y) * __builtin_amdgcn_rcpf(fmaxf(bf_lo(gg.y), 1e-30f)); r0[3] = bf_hi(ga.y) * __builtin_amdgcn_rcpf(fmaxf(bf_hi(gg.y), 1e-30f));
                        r1[0] = bf_lo(ga.z) * __builtin_amdgcn_rcpf(fmaxf(bf_lo(gg.z), 1e-30f)); r1[1] = bf_hi(ga.z) * __builtin_amdgcn_rcpf(fmaxf(bf_hi(gg.z), 1e-30f));
                        r1[2] = bf_lo(ga.w) * __builtin_amdgcn_rcpf(fmaxf(bf_lo(gg.w), 1e-30f)); r1[3] = bf_hi(ga.w) * __builtin_amdgcn_rcpf(fmaxf(bf_hi(gg.w), 1e-30f));
                        acc[ai][bj][m][0] *= r0; acc[ai][bj][m][1] *= r1;
                    }
                    if (m & 1) asm volatile("" ::: "memory"); }
#endif
        } else {
#pragma unroll
            for (int ai = 0; ai < 2; ++ai)
#pragma unroll
                for (int m = 0; m < 4; ++m) { const size_t ro = (size_t)(row0 + ai * HALF + m * 16);
#pragma unroll
                    for (int bj = 0; bj < 2; ++bj) {
#if defined(EXP_NOGATE)
                        const u32x4 gg = (u32x4){0x3f803f80u, 0x3f803f80u, 0x3f803f80u, 0x3f803f80u};
#else
                        const u32x4 gg = *(const u32x4*)(GATE + ro * 2048 + 1024 + col0 + bj * HALF);
#endif
                        f32x4 v0 = acc[ai][bj][m][0], v1 = acc[ai][bj][m][1];
                        v0[0] *= bf_lo(gg.x); v0[1] *= bf_hi(gg.x); v0[2] *= bf_lo(gg.y); v0[3] *= bf_hi(gg.y);
                        v1[0] *= bf_lo(gg.z); v1[1] *= bf_hi(gg.z); v1[2] *= bf_lo(gg.w); v1[3] *= bf_hi(gg.w);
                        *(u32x4*)(O + ro * 1024 + col0 + bj * HALF) = pack8(v0, v1);
                    }
                    if (m & 1) asm volatile("" ::: "memory"); }
        }
    }
};
struct SegOrder {
    StaticOrder S;
    __device__ __forceinline__ bool next(int i, Unit& u) const { if (!S.next(i >> 1, u)) return false; u.seg = i & 1; return true; }
    __device__ __forceinline__ void a_ready(const Unit&) const {}
    __device__ __forceinline__ void done(const Unit&) const {}
};

template <class Epi, class Sched, bool ALIGN_EPI = false, bool SP2 = false>
__device__ __forceinline__ void gemm_phase(PG8_LAS unsigned char* lds, const Gemm g, const Sched& S, const Epi& E) {
    const int tid = threadIdx.x, wid = __builtin_amdgcn_readfirstlane(tid >> 6), lane = tid & 63, wr = wid >> 2, wc = wid & 3, fr = lane & 15, fq = lane >> 4;
    const int K = g.K, nt = K / BK;
    unsigned voffA[2], voffB[2];
#pragma unroll
    for (int i = 0; i < 2; ++i) { int R, C; stage_rc(tid * 16 + i * 8192, R, C); const int Rb = Epi::PERM ? ((R & ~31) + perm32(R & 31)) : R;
        voffA[i] = (unsigned)(R * g.lda + C) * 2u; voffB[i] = (unsigned)(Rb * g.ldb + C) * 2u; }
    const size_t kstep = (size_t)(BK * 2);
    const size_t hstepA = (size_t)HALF * g.lda * 2, hstepB = (size_t)HALF * g.ldb * 2;
    const size_t tstepA = 2 * hstepA, tstepB = 2 * hstepB;
    const unsigned ldsw = (unsigned)wid * 1024u;
    const int aoff = lds_byte(wr * 64 + fr, fq * 8), boff = lds_byte(wc * 32 + fr, fq * 8);
#define PG8_SA(b, h) (((b) * 2 + (h)) * HTB)
#define PG8_SB(b, h) ((4 + (b) * 2 + (h)) * HTB)
#define PG8_STAGE(bufoff, gbase, voff) do { _Pragma("unroll") for (int _i = 0; _i < 2; ++_i) \
        __builtin_amdgcn_global_load_lds((const unsigned*)((const char*)(gbase) + (voff)[_i]), (PG8_LAS unsigned*)(lds + (bufoff) + ldsw + _i * 8192), 16, 0, 0); } while (0)
#define PG8_LDA(dst, b, h) do { _Pragma("unroll") for (int m = 0; m < 4; ++m) _Pragma("unroll") for (int k = 0; k < 2; ++k) dst[m][k] = *(const PG8_LAS bf16x8*)(lds + PG8_SA(b, h) + aoff + m * 2048 + k * 1024); } while (0)
#define PG8_LDB(dst, b, h) do { _Pragma("unroll") for (int n = 0; n < 2; ++n) _Pragma("unroll") for (int k = 0; k < 2; ++k) dst[n][k] = *(const PG8_LAS bf16x8*)(lds + PG8_SB(b, h) + boff + n * 2048 + k * 1024); } while (0)
#define PG8_MMA(ai, bj, At, Bt) do { __builtin_amdgcn_s_setprio(1); _Pragma("unroll") for (int m = 0; m < 4; ++m) _Pragma("unroll") for (int n = 0; n < 2; ++n) _Pragma("unroll") for (int k = 0; k < 2; ++k) \
        acc[ai][bj][m][n] = __builtin_amdgcn_mfma_f32_16x16x32_bf16(Bt[n][k], At[m][k], acc[ai][bj][m][n], 0, 0, 0); __builtin_amdgcn_s_setprio(0); } while (0)
#define PG8_WAIT_V(n) asm volatile("s_waitcnt vmcnt(" #n ")" ::: "memory")
#define PG8_WAIT_L(n) asm volatile("s_waitcnt lgkmcnt(" #n ")" ::: "memory")
#define PG8_BAR __builtin_amdgcn_s_barrier()
#define PG8_SCHED __builtin_amdgcn_sched_barrier(0)
    Unit cur, nxt; int ui = 0;
    if (!S.next(0, cur)) return;
    f32x4 acc[2][2][4][2];
#pragma unroll
    for (int a = 0; a < 2; ++a)
#pragma unroll
        for (int b = 0; b < 2; ++b)
#pragma unroll
            for (int m = 0; m < 4; ++m)
#pragma unroll
                for (int n = 0; n < 2; ++n) acc[a][b][m][n] = (f32x4){0.f, 0.f, 0.f, 0.f};
    bf16x8 At[4][2], B0[2][2], B1[2][2];
    const char* cA = (const char*)g.A + (size_t)cur.pm * tstepA + (size_t)cur.seg * g.segoff; const char* cB = (const char*)g.Bt + (size_t)cur.pn * tstepB + (size_t)cur.seg * g.segoff;
    S.a_ready(cur);
    if constexpr (SP2) {
        PG8_STAGE(PG8_SB(0, 0), cB, voffB); PG8_STAGE(PG8_SB(0, 1), cB + hstepB, voffB); PG8_STAGE(PG8_SA(0, 0), cA, voffA); PG8_STAGE(PG8_SA(0, 1), cA + hstepA, voffA);
        if (wr == 1) PG8_BAR;
        PG8_WAIT_V(2); PG8_BAR;
        PG8_STAGE(PG8_SB(1, 0), cB + kstep, voffB); PG8_STAGE(PG8_SA(1, 0), cA + kstep, voffA); PG8_STAGE(PG8_SB(1, 1), cB + hstepB + kstep, voffB);
        PG8_WAIT_V(6); PG8_BAR;
    } else {
        PG8_STAGE(PG8_SB(0, 0), cB, voffB); PG8_STAGE(PG8_SA(0, 0), cA, voffA); PG8_STAGE(PG8_SB(0, 1), cB + hstepB, voffB); PG8_STAGE(PG8_SA(0, 1), cA + hstepA, voffA);
        if (wr == 1) PG8_BAR;
        PG8_WAIT_V(4); PG8_BAR;
        PG8_STAGE(PG8_SB(1, 0), cB + kstep, voffB); PG8_STAGE(PG8_SA(1, 0), cA + kstep, voffA); PG8_STAGE(PG8_SB(1, 1), cB + hstepB + kstep, voffB);
        PG8_WAIT_V(6); PG8_BAR;
    }
    for (;;) {
        const bool has_next = S.next(ui + 1, nxt);
        const char* nA = has_next ? (const char*)g.A + (size_t)nxt.pm * tstepA + (size_t)nxt.seg * g.segoff : cA; const char* nB = has_next ? (const char*)g.Bt + (size_t)nxt.pn * tstepB + (size_t)nxt.seg * g.segoff : cB;
        for (int t = 0; t < nt; t += 2) {
            const bool last = (t == nt - 2);
            const char* a1 = cA + (size_t)(t + 1) * kstep;
            const char* a2 = last ? nA : cA + (size_t)(t + 2) * kstep; const char* b2 = last ? nB : cB + (size_t)(t + 2) * kstep;
            const char* a3 = a2 + kstep; const char* b3 = b2 + kstep;
            if (last && has_next) S.a_ready(nxt);
            if constexpr (SP2) {
            PG8_LDB(B0, 0, 0); PG8_LDB(B1, 0, 1); PG8_SCHED; PG8_LDA(At, 0, 0); PG8_STAGE(PG8_SA(1, 1), a1 + hstepA, voffA);
            PG8_WAIT_V(8); PG8_WAIT_L(0); PG8_BAR; PG8_MMA(0, 0, At, B0); PG8_MMA(0, 1, At, B1); PG8_BAR; PG8_SCHED;
            PG8_LDA(At, 0, 1); PG8_STAGE(PG8_SB(0, 0), b2, voffB); PG8_STAGE(PG8_SB(0, 1), b2 + hstepB, voffB); PG8_STAGE(PG8_SA(0, 0), a2, voffA);
            PG8_WAIT_V(8); PG8_WAIT_L(0); PG8_BAR; PG8_MMA(1, 0, At, B0); PG8_MMA(1, 1, At, B1); PG8_BAR; PG8_SCHED;
            PG8_LDB(B0, 1, 0); PG8_LDB(B1, 1, 1); PG8_SCHED; PG8_LDA(At, 1, 0); PG8_STAGE(PG8_SA(0, 1), a2 + hstepA, voffA);
            PG8_WAIT_V(8); PG8_WAIT_L(0); PG8_BAR; PG8_MMA(0, 0, At, B0); PG8_MMA(0, 1, At, B1); PG8_BAR; PG8_SCHED;
            PG8_LDA(At, 1, 1); PG8_STAGE(PG8_SB(1, 0), b3, voffB); PG8_STAGE(PG8_SB(1, 1), b3 + hstepB, voffB); PG8_STAGE(PG8_SA(1, 0), a3, voffA);
            PG8_WAIT_V(8); PG8_WAIT_L(0); PG8_BAR; PG8_MMA(1, 0, At, B0); PG8_MMA(1, 1, At, B1); PG8_BAR; PG8_SCHED;
            } else {
            PG8_LDB(B0, 0, 0); PG8_SCHED; PG8_LDA(At, 0, 0); PG8_STAGE(PG8_SA(1, 1), a1 + hstepA, voffA);
            PG8_WAIT_L(8); PG8_BAR; PG8_WAIT_L(0); PG8_MMA(0, 0, At, B0); PG8_BAR; PG8_SCHED;
            PG8_LDB(B1, 0, 1); PG8_STAGE(PG8_SB(0, 0), b2, voffB);
            PG8_BAR; PG8_WAIT_L(0); PG8_MMA(0, 1, At, B1); PG8_BAR;
            PG8_LDA(At, 0, 1); PG8_STAGE(PG8_SA(0, 0), a2, voffA);
            PG8_BAR; PG8_WAIT_L(0); PG8_MMA(1, 0, At, B0); PG8_BAR; PG8_SCHED;
            PG8_STAGE(PG8_SB(0, 1), b2 + hstepB, voffB);
            PG8_WAIT_V(6); PG8_BAR; PG8_MMA(1, 1, At, B1); PG8_BAR;
            PG8_LDB(B0, 1, 0); PG8_SCHED; PG8_LDA(At, 1, 0); PG8_STAGE(PG8_SA(0, 1), a2 + hstepA, voffA);
            PG8_WAIT_L(8); PG8_BAR; PG8_WAIT_L(0); PG8_MMA(0, 0, At, B0); PG8_BAR; PG8_SCHED;
            PG8_LDB(B1, 1, 1); PG8_STAGE(PG8_SB(1, 0), b3, voffB);
            PG8_BAR; PG8_WAIT_L(0); PG8_MMA(0, 1, At, B1); PG8_BAR;
            PG8_LDA(At, 1, 1); PG8_STAGE(PG8_SA(1, 0), a3, voffA);
            PG8_BAR; PG8_WAIT_L(0); PG8_MMA(1, 0, At, B0); PG8_BAR; PG8_SCHED;
            PG8_STAGE(PG8_SB(1, 1), b3 + hstepB, voffB);
            PG8_WAIT_V(6); PG8_BAR; PG8_MMA(1, 1, At, B1); PG8_BAR;
            }
        }
        if constexpr (ALIGN_EPI) { if (wr == 0) PG8_BAR; }
        if constexpr (!Epi::AFTER_DRAIN) { E(acc, cur, wr, wc, fr, fq); S.done(cur); }
        if (!has_next) break;
        if (nxt.seg == 0)
#pragma unroll
        for (int a = 0; a < 2; ++a)
#pragma unroll
            for (int b = 0; b < 2; ++b)
#pragma unroll
                for (int m = 0; m < 4; ++m)
#pragma unroll
                    for (int n = 0; n < 2; ++n) acc[a][b][m][n] = (f32x4){0.f, 0.f, 0.f, 0.f};
        cur = nxt; cA = nA; cB = nB; ++ui;
        if constexpr (ALIGN_EPI) { if (wr == 1) PG8_BAR; }
    }
    PG8_WAIT_V(0);
    if constexpr (!ALIGN_EPI) { if (wr == 0) PG8_BAR; }
    PG8_BAR;
    if constexpr (Epi::AFTER_DRAIN) { E.fused(acc, cur, wr, wc, fr, fq, lds, wid, lane); S.done(cur); }
#undef PG8_SA
#undef PG8_SB
#undef PG8_STAGE
#undef PG8_LDA
#undef PG8_LDB
#undef PG8_MMA
#undef PG8_WAIT_V
#undef PG8_WAIT_L
#undef PG8_BAR
#undef PG8_SCHED
}
}

constexpr int NWAVES = 8, NTHREADS = 512;
constexpr int BATCH = 4, SEQ = 8192, D = 1024, M = BATCH * SEQ, DFF = 2816, NFI = 2 * DFF, INW = 3840, NADA = 9 * D;
constexpr float EPS = 1e-6f;
#ifndef MK_N_LAUNCHES
#define MK_N_LAUNCHES 1
#endif
#ifndef DBG_STOP
#define DBG_STOP 13
#endif
#ifndef DBG_DUMP
#define DBG_DUMP 0
#endif
constexpr int N_PHASES = 13;
constexpr int N_LAUNCHES = MK_N_LAUNCHES;
constexpr size_t MiB = 1u << 20;
constexpr size_t WS_CTL = 0, CTL_ZERO_BYTES = 1 * MiB;
constexpr size_t WS_ADA = 1 * MiB, WS_DV = 1 * MiB + 256 * 1024, WS_WSM = 1 * MiB + 512 * 1024, WS_X = 2 * MiB;
constexpr size_t WS_W1I = 4 * MiB, WS_W1O = 15 * MiB, WS_WIN = 21 * MiB, WS_WBR = 29 * MiB, WS_WOUT = 31 * MiB, WS_W2I = 33 * MiB, WS_W2O = 44 * MiB;
constexpr size_t WS_XN = 50 * MiB, WS_QKV = 114 * MiB, WS_ZG = 162 * MiB, WS_GATE = 226 * MiB, WS_ACT = 114 * MiB, WS_MIXED = 162 * MiB, WS_CAT = 354 * MiB, WS_Y = 354 * MiB, WS_END = 482 * MiB;
static_assert(WS_W1I + (size_t)NFI * D * 2 <= WS_W1O && WS_W1O + (size_t)D * DFF * 2 <= WS_WIN && WS_WIN + (size_t)INW * D * 2 <= WS_WBR && WS_W2I + (size_t)NFI * D * 2 <= WS_W2O && WS_W2O + (size_t)D * DFF * 2 <= WS_XN, "weights map");
static_assert(WS_XN + (size_t)M * D * 2 <= WS_QKV && WS_QKV + (size_t)M * 768 * 2 <= WS_ZG && WS_ZG + (size_t)M * 1024 * 2 <= WS_GATE && WS_GATE + (size_t)M * 2048 * 2 <= WS_CAT && WS_ACT + (size_t)M * DFF * 2 <= WS_CAT && WS_Y + (size_t)M * D * 4 <= WS_END, "activation map");
constexpr int CW_TMO = 0, CW_CODE = 1, CW_BAR = 4096;
constexpr int RING_OFF = 0, RING_BYTES = 131072, LDSCTL_OFF = RING_BYTES, MISC_OFF = LDSCTL_OFF + 320, LDS_BYTES = 147456;

#define GAS __attribute__((address_space(1)))
#define LAS __attribute__((address_space(3)))
typedef unsigned short bf16;
typedef unsigned v4u __attribute__((ext_vector_type(4)));
typedef float f32x4 __attribute__((ext_vector_type(4)));
typedef short bf16x8 __attribute__((ext_vector_type(8)));
typedef GAS unsigned gu32;
typedef GAS unsigned long long gu64;
#define RLX_AGENT __ATOMIC_RELAXED, __HIP_MEMORY_SCOPE_AGENT
#define LDS_WAIT() asm volatile("s_waitcnt lgkmcnt(0)" ::: "memory")
#define VM_WAIT() asm volatile("s_waitcnt vmcnt(0)" ::: "memory")
__device__ __forceinline__ unsigned long long rt() { return __builtin_amdgcn_s_memrealtime(); }
__device__ __forceinline__ unsigned f2bf(float f) { unsigned u = __builtin_bit_cast(unsigned, f); return (u + 0x7fffu + ((u >> 16) & 1u)) >> 16; }
__device__ __forceinline__ unsigned pk2(float lo, float hi) { return f2bf(lo) | (f2bf(hi) << 16); }

#define XB_TMO      128
#define XB_XCNT(j)  (256  + 64 * (j))
#define XB_XSUB(j)  (1280 + 64 * (j))
#define XB_XGEN(j)  (2304 + 64 * (j))
#define XB_TOP      3328
#define XB_TOPGEN   3392
#define XCD_BAR_WORDS 3456
#define XB_SPIN_CAP (1u << 18)

__device__ __forceinline__ unsigned xb_ld(unsigned* p)              { return __hip_atomic_load(p, __ATOMIC_RELAXED, __HIP_MEMORY_SCOPE_AGENT); }
__device__ __forceinline__ unsigned xb_add(unsigned* p, unsigned v) { return __hip_atomic_fetch_add(p, v, __ATOMIC_RELAXED, __HIP_MEMORY_SCOPE_AGENT); }
__device__ __forceinline__ unsigned xb_xcc_id() { return (unsigned)__builtin_amdgcn_s_getreg((3 << 11) | 20) & 0xFu; }
#define XB_SPIN(cond, bar) do { unsigned _sp = 0; while (cond) { __builtin_amdgcn_s_sleep(1); \
    if ((++_sp & 255u) == 0u) { if (xb_ld(&(bar)[XB_TMO])) break; if (_sp > XB_SPIN_CAP) { atomicAdd(&(bar)[XB_TMO], 1u); break; } } } } while (0)

struct XcdBarrier {
    unsigned* bar; unsigned x;
    volatile LAS unsigned* st;
};

__device__ __forceinline__ XcdBarrier xcd_barrier_post(unsigned* bar, volatile LAS unsigned* st) {
    XcdBarrier b; b.bar = bar; b.x = xb_xcc_id(); b.st = st;
    if (threadIdx.x == 0) (void)xb_add(&bar[XB_XCNT(b.x)], 1u);
    return b;
}
__device__ __forceinline__ void xcd_barrier_complete(unsigned* bar, unsigned x, unsigned& nloc, unsigned& nx) {
    const unsigned G = gridDim.x * gridDim.y * gridDim.z;
    unsigned sum, cnt, mine, sp = 0u;
    for (;;) {
        sum = 0u; cnt = 0u; mine = 0u;
#pragma unroll
        for (unsigned j = 0; j < 16; ++j) { const unsigned c = xb_ld(&bar[XB_XCNT(j)]); sum += c; cnt += (c > 0u) ? 1u : 0u; mine = (j == x) ? c : mine; }
        if (sum == G) break;
        __builtin_amdgcn_s_sleep(1);
        if ((++sp & 255u) == 0u) { if (xb_ld(&bar[XB_TMO])) break; if (sp > XB_SPIN_CAP) { atomicAdd(&bar[XB_TMO], 1u); break; } }
    }
    nloc = mine > 0u ? mine : 1u; nx = cnt > 0u ? cnt : 1u;
}

__device__ __forceinline__ void xcd_barrier(const XcdBarrier& b) {
    asm volatile("s_waitcnt vmcnt(0)" ::: "memory");
    __syncthreads();
    if (threadIdx.x == 0) {
        unsigned* bar = b.bar;
        __builtin_amdgcn_s_waitcnt(0);
        unsigned nloc = b.st[0], nx = b.st[1];
        if (nloc == 0u) { xcd_barrier_complete(bar, b.x, nloc, nx); b.st[0] = nloc; b.st[1] = nx; }
        const unsigned old = xb_add(&bar[XB_XSUB(b.x)], 1u);
        const unsigned gen = old / nloc;
        if (old + 1u == (gen + 1u) * nloc) {
            __builtin_amdgcn_fence(__ATOMIC_RELEASE, "agent");
            asm volatile("s_waitcnt vmcnt(0)" ::: "memory");
            const unsigned og = xb_add(&bar[XB_TOP], 1u);
            const unsigned tg = og / nx;
            if (og + 1u == (tg + 1u) * nx) xb_add(&bar[XB_TOPGEN], 1u);
            else XB_SPIN(xb_ld(&bar[XB_TOPGEN]) == tg, bar);
            __builtin_amdgcn_fence(__ATOMIC_ACQUIRE, "agent");
            xb_add(&bar[XB_XGEN(b.x)], 1u);
            asm volatile("s_waitcnt vmcnt(0)" ::: "memory");
        } else {
            XB_SPIN(xb_ld(&bar[XB_XGEN(b.x)]) == gen, bar);
            __builtin_amdgcn_fence(__ATOMIC_ACQUIRE, "agent");
            asm volatile("s_waitcnt vmcnt(0)" ::: "memory");
        }
    }
    __syncthreads();
}

__device__ __forceinline__ float wave_sum(float v) {
#pragma unroll
    for (int o = 1; o < 64; o <<= 1) v += __shfl_xor(v, o);
    return v;
}
__device__ __forceinline__ float wave_max(float v) {
#pragma unroll
    for (int o = 1; o < 64; o <<= 1) v = fmaxf(v, __shfl_xor(v, o));
    return v;
}
__device__ __forceinline__ float bf2f(bf16 h) { return __uint_as_float((unsigned)h << 16); }
__device__ __forceinline__ float bflo(unsigned w) { return __uint_as_float(w << 16); }
__device__ __forceinline__ float bfhi(unsigned w) { return __uint_as_float(w & 0xffff0000u); }

struct Args { const float* in[20]; float* out; unsigned char* ws; int ph_lo, ph_hi; };

__device__ __forceinline__ void tr_item(const float* W, int N, bf16* WT, int ldk, int kdst0, int drow0, int k0, int n0, LAS float* scr, int lane) {
#pragma unroll 8
    for (int i = 0; i < 32; ++i) { const int kk = 2 * i + (lane >> 5); scr[kk * 33 + (lane & 31)] = W[(size_t)(k0 + kk) * N + n0 + (lane & 31)]; }
    LDS_WAIT(); asm volatile("" ::: "memory");
    const int c = lane & 7;
#pragma unroll
    for (int j = 0; j < 4; ++j) { const int n = (lane >> 3) + 8 * j; const LAS float* s = scr + (8 * c) * 33 + n;
        v4u o; o.x = pk2(s[0 * 33], s[1 * 33]); o.y = pk2(s[2 * 33], s[3 * 33]); o.z = pk2(s[4 * 33], s[5 * 33]); o.w = pk2(s[6 * 33], s[7 * 33]);
        *(GAS v4u*)(WT + (size_t)(drow0 + n) * ldk + kdst0 + k0 + 8 * c) = o; }
    LDS_WAIT(); asm volatile("" ::: "memory");
}
__device__ __forceinline__ void tr_matrix(const float* W, int K, int N, bf16* WT, int ldk, int kdst0, bool ffnmap, int r, LAS float* scr, int lane) {
    const int nblk = N / 32, kb = r / nblk, nb = r % nblk, n0 = 32 * nb;
    int drow0 = n0;
    if (ffnmap) { const int up = n0 >= DFF, j = up ? n0 - DFF : n0; drow0 = 256 * (j >> 7) + (up ? 128 : 0) + (j & 127); }
    tr_item(W, N, WT, ldk, kdst0, drow0, 64 * kb, n0, scr, lane);
}

__device__ __forceinline__ void phase_p0a(const Args& a, LAS unsigned char* lds, int tid, int lane, int wave, int vcu, int G) {
    unsigned char* ws = a.ws;
    float* ADA = (float*)(ws + WS_ADA);
    LAS float* scT = (LAS float*)(lds + 98304);
    LAS float* red = (LAS float*)(lds + 114688);
    for (int i = tid; i < BATCH * D; i += NTHREADS) { const float v = a.in[1][i]; scT[i] = v / (1.f + __expf(-v)); }
    __syncthreads();
    for (int item = blockIdx.x; item < NADA / 64; item += G) {
        const float* w = a.in[3] + (size_t)(wave * 128) * NADA + item * 64 + lane;
        float a0 = 0.f, a1 = 0.f, a2 = 0.f, a3 = 0.f;
#pragma unroll 16
        for (int k = 0; k < 128; ++k) { const float wv = w[(size_t)k * NADA]; const int kk = wave * 128 + k;
            a0 += scT[kk] * wv; a1 += scT[1024 + kk] * wv; a2 += scT[2048 + kk] * wv; a3 += scT[3072 + kk] * wv; }
        red[(wave * 4 + 0) * 64 + lane] = a0; red[(wave * 4 + 1) * 64 + lane] = a1; red[(wave * 4 + 2) * 64 + lane] = a2; red[(wave * 4 + 3) * 64 + lane] = a3;
        __syncthreads();
        if (wave < 4) { float s = a.in[4][item * 64 + lane];
#pragma unroll
            for (int w8 = 0; w8 < 8; ++w8) s += red[(w8 * 4 + wave) * 64 + lane];
            ADA[wave * NADA + item * 64 + lane] = s; }
        __syncthreads();
    }
    { const int gt = blockIdx.x * NTHREADS + tid;
        bf16* WSM = (bf16*)(ws + WS_WSM);
        for (int i = gt; i < 8 * 128 * 128; i += G * NTHREADS) { const int s = i & 127, t = (i >> 7) & 127; WSM[i] = (s <= t) ? (bf16)f2bf(a.in[13][i]) : (bf16)0; } }
    LAS float* scr = (LAS float*)(lds + wave * 12288);
    const int gw = vcu * NWAVES + wave, NGW = G * NWAVES;
    constexpr int I_FI = (D / 64) * (NFI / 32), I_FO = (DFF / 64) * (D / 32), I_IN = (D / 64) * (INW / 32), I_BR = (512 / 64) * (D / 32), I_O = (D / 64) * (D / 32);
    constexpr int NITEMS = 2 * I_FI + 2 * I_FO + I_IN + 2 * I_BR + I_O;
    for (int it = gw; it < NITEMS; it += NGW) {
        int r = it;
        if (r < I_FI) { tr_matrix(a.in[7], D, NFI, (bf16*)(ws + WS_W1I), D, 0, true, r, scr, lane); continue; } r -= I_FI;
        if (r < I_FI) { tr_matrix(a.in[18], D, NFI, (bf16*)(ws + WS_W2I), D, 0, true, r, scr, lane); continue; } r -= I_FI;
        if (r < I_FO) { tr_matrix(a.in[8], DFF, D, (bf16*)(ws + WS_W1O), DFF, 0, false, r, scr, lane); continue; } r -= I_FO;
        if (r < I_FO) { tr_matrix(a.in[19], DFF, D, (bf16*)(ws + WS_W2O), DFF, 0, false, r, scr, lane); continue; } r -= I_FO;
        if (r < I_IN) { tr_matrix(a.in[9], D, INW, (bf16*)(ws + WS_WIN), D, 0, false, r, scr, lane); continue; } r -= I_IN;
        if (r < I_BR) { tr_matrix(a.in[15], 512, D, (bf16*)(ws + WS_WBR), D, 0, false, r, scr, lane); continue; } r -= I_BR;
        if (r < I_BR) { tr_matrix(a.in[16], 512, D, (bf16*)(ws + WS_WBR), D, 512, false, r, scr, lane); continue; } r -= I_BR;
        tr_matrix(a.in[17], D, D, (bf16*)(ws + WS_WOUT), D, 0, false, r, scr, lane);
    }
}

__device__ __forceinline__ void phase_p0b(const Args& a, int tid, int lane, int wave, int vcu, int G) {
    unsigned char* ws = a.ws;
    const float* ADA = (const float*)(ws + WS_ADA); float* DV = (float*)(ws + WS_DV); bf16* XN = (bf16*)(ws + WS_XN);
    for (int idx = blockIdx.x * NTHREADS + tid; idx < 36 * 1024; idx += G * NTHREADS) {
        const int col = idx & 1023, q = idx >> 10, kind = q % 3, sb = q / 3, s = sb >> 2, b = sb & 3;
        const float* ad = ADA + b * NADA + 3 * s * 1024;
        float v;
        if (kind == 0) v = a.in[5][s * 1024 + col] * (1.f + ad[1024 + col]);
        else if (kind == 1) v = ad[col];
        else v = (s == 1 ? 1.f : 0.5f) * ad[2048 + col] * a.in[6][s * 1024 + col];
        DV[idx] = v;
    }
    const int gw = vcu * NWAVES + wave, NGW = G * NWAVES;
    for (int m = gw; m < M; m += NGW) {
        const int b = m >> 13;
        const GAS f32x4* xr = (const GAS f32x4*)(a.in[0] + (size_t)m * D) + lane;
        f32x4 v[4]; float s = 0.f;
#pragma unroll
        for (int j = 0; j < 4; ++j) { v[j] = xr[64 * j]; s += (v[j].x * v[j].x + v[j].y * v[j].y) + (v[j].z * v[j].z + v[j].w * v[j].w); }
        const float rstd = 1.f / sqrtf(wave_sum(s) * (1.f / D) + EPS);
        GAS unsigned long long* o8 = (GAS unsigned long long*)(XN + (size_t)m * D) + lane;
#pragma unroll
        for (int j = 0; j < 4; ++j) { const int col = 4 * lane + 256 * j;
            const f32x4 g = *(const f32x4*)(a.in[5] + col), sc = *(const f32x4*)(ADA + b * NADA + 1024 + col), sh = *(const f32x4*)(ADA + b * NADA + col);
            const f32x4 o = v[j] * rstd * (g * (1.f + sc)) + sh;
            o8[64 * j] = (unsigned long long)pk2(o.x, o.y) | ((unsigned long long)pk2(o.z, o.w) << 32); }
    }
}

__device__ __forceinline__ void phase_rownorm(const Args& a, int s, const float* base, bool has_next, int lane, int wave, int vcu, int G) {
    unsigned char* ws = a.ws;
    const float* DV = (const float*)(ws + WS_DV); const float* Y = (const float*)(ws + WS_Y); bf16* XN = (bf16*)(ws + WS_XN);
    const int gw = vcu * NWAVES + wave, NGW = G * NWAVES;
    for (int m = gw; m < M; m += NGW) {
        const int b = m >> 13;
        const float* dv = DV + (size_t)((s * 4 + b) * 3) * 1024;
        const GAS f32x4* yr = (const GAS f32x4*)(Y + (size_t)m * D) + lane;
        const GAS f32x4* br = (const GAS f32x4*)(base + (size_t)m * D) + lane;
        GAS f32x4* orow = (GAS f32x4*)(a.out + (size_t)m * D) + lane;
        f32x4 y[4], h[4]; float sq = 0.f;
#pragma unroll
        for (int j = 0; j < 4; ++j) { y[j] = yr[64 * j]; h[j] = br[64 * j]; sq += (y[j].x * y[j].x + y[j].y * y[j].y) + (y[j].z * y[j].z + y[j].w * y[j].w); }
        const float rstd = 1.f / sqrtf(wave_sum(sq) * (1.f / D) + EPS);
        float sq2 = 0.f;
#pragma unroll
        for (int j = 0; j < 4; ++j) { const f32x4 g = *(const f32x4*)(dv + 2048 + 4 * lane + 256 * j);
            h[j] = h[j] + g * y[j] * rstd; orow[64 * j] = h[j];
            sq2 += (h[j].x * h[j].x + h[j].y * h[j].y) + (h[j].z * h[j].z + h[j].w * h[j].w); }
        if (has_next) {
            const float* dn = DV + (size_t)(((s + 1) * 4 + b) * 3) * 1024;
            const float rstd2 = 1.f / sqrtf(wave_sum(sq2) * (1.f / D) + EPS);
            GAS unsigned long long* o8 = (GAS unsigned long long*)(XN + (size_t)m * D) + lane;
#pragma unroll
            for (int j = 0; j < 4; ++j) { const int col = 4 * lane + 256 * j;
                const f32x4 A = *(const f32x4*)(dn + col), sh = *(const f32x4*)(dn + 1024 + col);
                const f32x4 o = h[j] * rstd2 * A + sh;
                o8[64 * j] = (unsigned long long)pk2(o.x, o.y) | ((unsigned long long)pk2(o.z, o.w) << 32); }
        }
    }
}

__device__ __forceinline__ void phase_mix_simple(const Args& a, LAS unsigned char* lds, int tid, int lane, int wave, int vcu, int G) {
    unsigned char* ws = a.ws;
    const bf16* QKV = (const bf16*)(ws + WS_QKV); const bf16* ZG = (const bf16*)(ws + WS_ZG); bf16* CAT = (bf16*)(ws + WS_CAT);
    for (int unit = vcu; unit < 256; unit += G) {
        const int b = unit >> 6, ci = unit & 63; const size_t r0 = (size_t)b * SEQ + (size_t)ci * 128;
        LAS float* biasT = (LAS float*)lds;
        LAS float* qs = (LAS float*)(lds + 4096) + wave * 64;
        LAS float* ps = (LAS float*)(lds + 4096 + 2048) + wave * 128;
        for (int i = tid; i < 1024; i += NTHREADS) { const int h = i >> 7, d = i & 127;
            int bk = d; if (d >= 16) { bk = 16 + (int)(logf((float)d * (1.f / 16.f)) / logf(8.f) * 16.f); bk = bk > 31 ? 31 : bk; }
            biasT[i] = a.in[2][bk * 8 + h]; }
        __syncthreads();
        {   const int h = wave, kvh = h >> 2; const float sink = a.in[10][h];
            for (int tl = 0; tl < 128; ++tl) {
                const size_t row = r0 + tl;
                qs[lane] = bf2f(QKV[row * 768 + h * 64 + lane]);
                asm volatile("s_waitcnt lgkmcnt(0)" ::: "memory");
                float sc[2];
#pragma unroll
                for (int e = 0; e < 2; ++e) { const int dist = lane + 64 * e; const int kp = ci * 128 + tl - dist; const bool valid = kp >= 0;
                    const bf16* kptr = QKV + ((size_t)b * SEQ + (valid ? kp : 0)) * 768 + 512 + kvh * 64;
                    float acc = 0.f;
#pragma unroll
                    for (int c8 = 0; c8 < 8; ++c8) { const v4u kv = *(const GAS v4u*)(kptr + 8 * c8);
                        const f32x4 q0 = *(const LAS f32x4*)(qs + 8 * c8), q1 = *(const LAS f32x4*)(qs + 8 * c8 + 4);
                        acc += bflo(kv.x) * q0.x + bfhi(kv.x) * q0.y + bflo(kv.y) * q0.z + bfhi(kv.y) * q0.w + bflo(kv.z) * q1.x + bfhi(kv.z) * q1.y + bflo(kv.w) * q1.z + bfhi(kv.w) * q1.w; }
                    sc[e] = valid ? acc + biasT[h * 128 + dist] : -1e30f; }
                const float mx = fmaxf(wave_max(fmaxf(sc[0], sc[1])), sink);
                const float p0 = __expf(sc[0] - mx), p1 = __expf(sc[1] - mx);
                const float denom = wave_sum(p0 + p1) + __expf(sink - mx);
                ps[lane] = p0; ps[lane + 64] = p1;
                asm volatile("s_waitcnt lgkmcnt(0)" ::: "memory");
                float o = 0.f;
                const int nk = min(128, ci * 128 + tl + 1);
                const bf16* vptr = QKV + ((size_t)b * SEQ + ci * 128 + tl) * 768 + 640 + kvh * 64 + lane;
#pragma unroll 8
                for (int dist = 0; dist < nk; ++dist) o += ps[dist] * bf2f(vptr[-(ptrdiff_t)dist * 768]);
                CAT[row * 1024 + h * 64 + lane] = (bf16)f2bf(o / denom);
                asm volatile("s_waitcnt lgkmcnt(0)" ::: "memory");
            }
        }
        __syncthreads();
        LAS bf16* vn = (LAS bf16*)lds;
        for (int tl = wave * 16; tl < wave * 16 + 16; ++tl) {
            const v4u raw = *(const GAS v4u*)(ZG + (r0 + tl) * 1024 + 512 + 8 * lane);
            float x[8] = {bflo(raw.x), bfhi(raw.x), bflo(raw.y), bfhi(raw.y), bflo(raw.z), bfhi(raw.z), bflo(raw.w), bfhi(raw.w)};
            float s = 0.f;
#pragma unroll
            for (int e = 0; e < 8; ++e) s += x[e];
            const float mu = wave_sum(s) * (1.f / 512.f); float q = 0.f;
#pragma unroll
            for (int e = 0; e < 8; ++e) { x[e] -= mu; q += x[e] * x[e]; }
            const float rstd = 1.f / sqrtf(wave_sum(q) * (1.f / 512.f) + EPS);
            const f32x4 g0 = *(const f32x4*)(a.in[11] + 8 * lane), g1 = *(const f32x4*)(a.in[11] + 8 * lane + 4), b0 = *(const f32x4*)(a.in[12] + 8 * lane), b1 = *(const f32x4*)(a.in[12] + 8 * lane + 4);
            v4u o; o.x = pk2(x[0] * rstd * g0.x + b0.x, x[1] * rstd * g0.y + b0.y); o.y = pk2(x[2] * rstd * g0.z + b0.z, x[3] * rstd * g0.w + b0.w);
            o.z = pk2(x[4] * rstd * g1.x + b1.x, x[5] * rstd * g1.y + b1.y); o.w = pk2(x[6] * rstd * g1.z + b1.z, x[7] * rstd * g1.w + b1.w);
            *(LAS v4u*)(vn + tl * 512 + 8 * lane) = o;
        }
        __syncthreads();
        {   const int ch = tid, g = wave;
            for (int tl = 0; tl < 128; ++tl) {
                const float* wrow = a.in[13] + (size_t)(g * 128 + tl) * 128;
                float acc = 0.f;
                for (int s = 0; s <= tl; ++s) acc += wrow[s] * bf2f(vn[s * 512 + ch]);
                const float sp = acc + a.in[14][g * 128 + tl];
                const float uu = bf2f(ZG[(r0 + tl) * 1024 + ch]);
                CAT[(r0 + tl) * 1024 + 512 + ch] = (bf16)f2bf(uu * sp);
            }
        }
        __syncthreads();
    }
}


typedef float f32x16 __attribute__((ext_vector_type(16)));
__device__ __forceinline__ int rowoff32(int i, int hh) { return (i & 3) + 8 * (i >> 2) + 4 * hh; }
__device__ __forceinline__ unsigned cvtpk(float lo, float hi) { return pg8::cvt_pk_bf16(lo, hi); }

__device__ __forceinline__ void attn_qblock(const bf16* QKV, bf16* CAT, LAS unsigned char* lds, size_t r0, int ci, int h, int qb, int lane, int wave, float sink) {
    int c = lane & 31, hh = lane >> 5; asm volatile("" : "+v"(c), "+v"(hh));
    const LAS bf16* Ks = (const LAS bf16*)lds; const LAS bf16* Vs = (const LAS bf16*)(lds + 36864);
    const LAS float* biasT = (const LAS float*)(lds + 73728) + h * 128;
    LAS float* wscr = (LAS float*)(lds + 77824) + wave * 32;
    bf16x8 qf[4];
    { const bf16* qp = QKV + (r0 + 32 * qb + c) * 768 + h * 64 + 8 * hh;
#pragma unroll
        for (int ks = 0; ks < 4; ++ks) qf[ks] = *(const GAS bf16x8*)(qp + 16 * ks); }
    f32x16 st[5];
#pragma unroll
    for (int t = 0; t < 5; ++t) {
        st[t] = (f32x16){0.f, 0.f, 0.f, 0.f, 0.f, 0.f, 0.f, 0.f, 0.f, 0.f, 0.f, 0.f, 0.f, 0.f, 0.f, 0.f};
        const LAS bf16* kp = Ks + (32 * (qb + t) + c) * 72 + 8 * hh;
#pragma unroll
        for (int ks = 0; ks < 4; ++ks) { const bf16x8 a = *(const LAS bf16x8*)(kp + 16 * ks); st[t] = __builtin_amdgcn_mfma_f32_32x32x16_bf16(a, qf[ks], st[t], 0, 0, 0); }
    }
    float mx = -1e30f;
#pragma unroll
    for (int t = 0; t < 5; ++t)
#pragma unroll
        for (int i = 0; i < 16; ++i) {
            const int ro = rowoff32(i, hh), dist = 128 - 32 * t + c - ro;
            bool valid = (ci > 0) || (32 * (qb + t) + ro >= 128);
            if (t == 0) valid = valid && (dist <= 127);
            if (t == 4) valid = valid && (dist >= 0);
            const float sv = valid ? st[t][i] + biasT[dist & 127] : -1e30f;
            st[t][i] = sv; mx = fmaxf(mx, sv);
        }
    mx = fmaxf(mx, __shfl_xor(mx, 32)); mx = fmaxf(mx, sink);
    float sum = 0.f;
#pragma unroll
    for (int t = 0; t < 5; ++t)
#pragma unroll
        for (int i = 0; i < 16; ++i) { const float p = __builtin_amdgcn_exp2f((st[t][i] - mx) * 1.4426950408889634f); st[t][i] = p; sum += p; }
    sum += __shfl_xor(sum, 32);
    const float inv = 1.f / (sum + __builtin_amdgcn_exp2f((sink - mx) * 1.4426950408889634f));
    if (hh == 0) wscr[c] = inv;
    f32x16 o[2];
    o[0] = (f32x16){0.f, 0.f, 0.f, 0.f, 0.f, 0.f, 0.f, 0.f, 0.f, 0.f, 0.f, 0.f, 0.f, 0.f, 0.f, 0.f}; o[1] = o[0];
#pragma unroll
    for (int t = 0; t < 5; ++t)
#pragma unroll
        for (int s2 = 0; s2 < 2; ++s2) {
            v4u pw; pw.x = cvtpk(st[t][8 * s2 + 0], st[t][8 * s2 + 1]); pw.y = cvtpk(st[t][8 * s2 + 2], st[t][8 * s2 + 3]); pw.z = cvtpk(st[t][8 * s2 + 4], st[t][8 * s2 + 5]); pw.w = cvtpk(st[t][8 * s2 + 6], st[t][8 * s2 + 7]);
            const bf16x8 pa = __builtin_bit_cast(bf16x8, pw);
            const LAS bf16* vp = Vs + (32 * (qb + t) + 16 * s2 + 4 * hh) * 72 + c;
#pragma unroll
            for (int db = 0; db < 2; ++db) {
                bf16x8 vb;
#pragma unroll
                for (int j = 0; j < 8; ++j) vb[j] = (short)vp[(8 * (j >> 2) + (j & 3)) * 72 + 32 * db];
                o[db] = __builtin_amdgcn_mfma_f32_32x32x16_bf16(pa, vb, o[db], 0, 0, 0);
            }
        }
    asm volatile("s_waitcnt lgkmcnt(0)" ::: "memory");
#pragma unroll
    for (int i = 0; i < 16; ++i) { const int ro = rowoff32(i, hh); const float iv = wscr[ro];
        bf16* op = CAT + (r0 + 32 * qb + ro) * 1024 + h * 64 + c;
        op[0] = (bf16)f2bf(o[0][i] * iv); op[32] = (bf16)f2bf(o[1][i] * iv); }
    asm volatile("s_waitcnt lgkmcnt(0)" ::: "memory");
}

__device__ __forceinline__ void phase_mix(const Args& a, LAS unsigned char* lds, int tid, int lane, int wave, int vcu, int G) {
    unsigned char* ws = a.ws;
    const bf16* QKV = (const bf16*)(ws + WS_QKV); const bf16* ZG = (const bf16*)(ws + WS_ZG); bf16* CAT = (bf16*)(ws + WS_CAT); const bf16* WSM = (const bf16*)(ws + WS_WSM);
    for (int unit = vcu; unit < 256; unit += G) {
        const int b = unit >> 6, ci = unit & 63; const size_t r0 = (size_t)b * SEQ + (size_t)ci * 128;
        { LAS float* biasT = (LAS float*)(lds + 73728);
            for (int i = tid; i < 1024; i += NTHREADS) { const int h = i >> 7, d = i & 127;
                int bk = d; if (d >= 16) { bk = 16 + (int)(logf((float)d * (1.f / 16.f)) / logf(8.f) * 16.f); bk = bk > 31 ? 31 : bk; }
                biasT[i] = a.in[2][bk * 8 + h]; } }
        for (int kvh = 0; kvh < 2; ++kvh) {
            if (kvh) __syncthreads();
#pragma unroll
            for (int i = 0; i < 4; ++i) { const int p = tid + NTHREADS * i, row = p >> 3, ch = p & 7;
                v4u kv = (v4u){0u, 0u, 0u, 0u}, vv = kv;
                if (ci > 0 || row >= 128) { const bf16* src = QKV + (r0 + row - 128) * 768 + 512 + kvh * 64 + 8 * ch; kv = *(const GAS v4u*)src; vv = *(const GAS v4u*)(src + 128); }
                *(LAS v4u*)(lds + row * 144 + ch * 16) = kv; *(LAS v4u*)(lds + 36864 + row * 144 + ch * 16) = vv; }
            __syncthreads();
            const int h = 4 * kvh + (wave & 3); const float sink = a.in[10][h];
            attn_qblock(QKV, CAT, lds, r0, ci, h, 2 * (wave >> 2), lane, wave, sink);
            attn_qblock(QKV, CAT, lds, r0, ci, h, 2 * (wave >> 2) + 1, lane, wave, sink);
        }
        __syncthreads();
        LAS bf16* vn = (LAS bf16*)lds;
        for (int tl = wave * 16; tl < wave * 16 + 16; ++tl) {
            const v4u raw = *(const GAS v4u*)(ZG + (r0 + tl) * 1024 + 512 + 8 * lane);
            float x[8] = {bflo(raw.x), bfhi(raw.x), bflo(raw.y), bfhi(raw.y), bflo(raw.z), bfhi(raw.z), bflo(raw.w), bfhi(raw.w)};
            float s = 0.f;
#pragma unroll
            for (int e = 0; e < 8; ++e) s += x[e];
            const float mu = wave_sum(s) * (1.f / 512.f); float q = 0.f;
#pragma unroll
            for (int e = 0; e < 8; ++e) { x[e] -= mu; q += x[e] * x[e]; }
            const float rstd = 1.f / sqrtf(wave_sum(q) * (1.f / 512.f) + EPS);
            const f32x4 g0 = *(const f32x4*)(a.in[11] + 8 * lane), g1 = *(const f32x4*)(a.in[11] + 8 * lane + 4), b0 = *(const f32x4*)(a.in[12] + 8 * lane), b1 = *(const f32x4*)(a.in[12] + 8 * lane + 4);
            v4u o; o.x = pk2(x[0] * rstd * g0.x + b0.x, x[1] * rstd * g0.y + b0.y); o.y = pk2(x[2] * rstd * g0.z + b0.z, x[3] * rstd * g0.w + b0.w);
            o.z = pk2(x[4] * rstd * g1.x + b1.x, x[5] * rstd * g1.y + b1.y); o.w = pk2(x[6] * rstd * g1.z + b1.z, x[7] * rstd * g1.w + b1.w);
            *(LAS v4u*)(vn + tl * 512 + 8 * lane) = o;
        }
        __syncthreads();
        {   const int g = wave; int c = lane & 31, hh = lane >> 5; asm volatile("" : "+v"(c), "+v"(hh));
            f32x16 acc[4][2];
#pragma unroll
            for (int tb = 0; tb < 4; ++tb) { acc[tb][0] = (f32x16){0.f, 0.f, 0.f, 0.f, 0.f, 0.f, 0.f, 0.f, 0.f, 0.f, 0.f, 0.f, 0.f, 0.f, 0.f, 0.f}; acc[tb][1] = acc[tb][0]; }
            const bf16* wg = WSM + (size_t)g * 128 * 128 + (size_t)c * 128 + 8 * hh;
#pragma unroll
            for (int ks = 0; ks < 8; ++ks) {
                bf16x8 vb[2];
                const LAS bf16* vp = vn + (16 * ks + 8 * hh) * 512 + g * 64 + c;
#pragma unroll
                for (int cb = 0; cb < 2; ++cb)
#pragma unroll
                    for (int j = 0; j < 8; ++j) vb[cb][j] = (short)vp[j * 512 + 32 * cb];
#pragma unroll
                for (int tb = 0; tb < 4; ++tb) if (2 * tb + 1 >= ks) {
                    const bf16x8 wa = *(const GAS bf16x8*)(wg + (size_t)tb * 32 * 128 + 16 * ks);
                    acc[tb][0] = __builtin_amdgcn_mfma_f32_32x32x16_bf16(wa, vb[0], acc[tb][0], 0, 0, 0);
                    acc[tb][1] = __builtin_amdgcn_mfma_f32_32x32x16_bf16(wa, vb[1], acc[tb][1], 0, 0, 0);
                }
            }
#pragma unroll
            for (int tb = 0; tb < 4; ++tb)
#pragma unroll
                for (int i = 0; i < 16; ++i) { const int t = 32 * tb + rowoff32(i, hh); const float bs = a.in[14][g * 128 + t];
                    const bf16* up = ZG + (r0 + t) * 1024 + g * 64 + c; bf16* op = CAT + (r0 + t) * 1024 + 512 + g * 64 + c;
                    op[0] = (bf16)f2bf(bf2f(up[0]) * (acc[tb][0][i] + bs)); op[32] = (bf16)f2bf(bf2f(up[32]) * (acc[tb][1][i] + bs)); }
        }
        __syncthreads();
    }
}

__global__ void __launch_bounds__(NTHREADS, 2) fwd_kernel(Args args) {
    extern __shared__ __attribute__((aligned(16))) unsigned char lds_raw[];
    LAS unsigned char* lds = (LAS unsigned char*)lds_raw;
    volatile LAS unsigned* MISC = (volatile LAS unsigned*)(lds + MISC_OFF);
    const int tid = threadIdx.x, lane = tid & 63, wave = __builtin_amdgcn_readfirstlane(tid >> 6);
    const int G = gridDim.x; const int bx = blockIdx.x; const int vcu = (G % 8 == 0) ? (bx % 8) * (G / 8) + bx / 8 : bx;
    unsigned char* ws = args.ws;
    gu32* ctl = (gu32*)(ws + WS_CTL);
    for (int u = tid; u < (LDS_BYTES - LDSCTL_OFF) / 4; u += NTHREADS) ((LAS unsigned*)(lds + LDSCTL_OFF))[u] = 0u;
    __syncthreads();
    XcdBarrier bar; bar.bar = (unsigned*)(ctl + CW_BAR); bar.x = 0; bar.st = nullptr;
    if (N_LAUNCHES == 1) bar = xcd_barrier_post((unsigned*)(ctl + CW_BAR), MISC + 8);
    const int lo = args.ph_lo, hi = args.ph_hi;
#define IN(k) (lo <= (k) && (k) < hi)
#define SEAM(k) do { if (IN(k) && IN((k) + 1)) xcd_barrier(bar); } while (0)
    bf16* XN = (bf16*)(ws + WS_XN); bf16* ACT = (bf16*)(ws + WS_ACT); float* Y = (float*)(ws + WS_Y);
    bf16* QKVb = (bf16*)(ws + WS_QKV); bf16* ZGb = (bf16*)(ws + WS_ZG); bf16* GATEb = (bf16*)(ws + WS_GATE); bf16* CATb = (bf16*)(ws + WS_CAT); bf16* MIXb = (bf16*)(ws + WS_MIXED);

    if (IN(0)) { phase_p0a(args, lds, tid, lane, wave, vcu, G); } SEAM(0);
    if (IN(1)) { phase_p0b(args, tid, lane, wave, vcu, G); } SEAM(1);
    if (IN(2)) {
        pg8::Gemm g{XN, (const bf16*)(ws + WS_W1I), M, NFI, D, D, D, 0}; pg8::StaticOrder S; S.init(M, NFI, G, bx);
        pg8::EpiSwiglu E{ACT, DFF};
        pg8::gemm_phase<pg8::EpiSwiglu, pg8::StaticOrder, true, true>(lds + RING_OFF, g, S, E);
    } SEAM(2);
    if (IN(3)) {
        pg8::Gemm g{ACT, (const bf16*)(ws + WS_W1O), M, D, DFF, DFF, DFF, 0}; pg8::StaticOrder S; S.init(M, D, G, bx);
        pg8::EpiF32 E{Y, D};
        pg8::gemm_phase<pg8::EpiF32, pg8::StaticOrder, true, true>(lds + RING_OFF, g, S, E);
    } SEAM(3);
    if (IN(4)) { phase_rownorm(args, 0, args.in[0], true, lane, wave, vcu, G); } SEAM(4);
    if (IN(5)) {
        pg8::Gemm g{XN, (const bf16*)(ws + WS_WIN), M, INW, D, D, D, 0}; pg8::StaticOrder S; S.init(M, INW, G, bx);
        pg8::EpiZ E{QKVb, ZGb, GATEb};
        pg8::gemm_phase<pg8::EpiZ, pg8::StaticOrder, true, true>(lds + RING_OFF, g, S, E);
    } SEAM(5);
    #if defined(MIX_SIMPLE)
    if (IN(6)) { phase_mix_simple(args, lds, tid, lane, wave, vcu, G); } SEAM(6);
#else
    if (IN(6)) { phase_mix(args, lds, tid, lane, wave, vcu, G); } SEAM(6);
#endif
    if (IN(7)) {
        pg8::Gemm g{CATb, (const bf16*)(ws + WS_WBR), M, D, 512, D, D, 1024}; pg8::SegOrder S; S.S.init(M, D, G, bx);
        pg8::EpiBr E{GATEb, MIXb};
        pg8::gemm_phase<pg8::EpiBr, pg8::SegOrder, true, true>(lds + RING_OFF, g, S, E);
    } SEAM(7);
    if (IN(8)) {
        pg8::Gemm g{MIXb, (const bf16*)(ws + WS_WOUT), M, D, D, D, D, 0}; pg8::StaticOrder S; S.init(M, D, G, bx);
        pg8::EpiF32 E{Y, D};
        pg8::gemm_phase<pg8::EpiF32, pg8::StaticOrder, true, true>(lds + RING_OFF, g, S, E);
    } SEAM(8);
    if (IN(9)) { phase_rownorm(args, 1, args.out, true, lane, wave, vcu, G); } SEAM(9);
    if (IN(10)) {
        pg8::Gemm g{XN, (const bf16*)(ws + WS_W2I), M, NFI, D, D, D, 0}; pg8::StaticOrder S; S.init(M, NFI, G, bx);
        pg8::EpiSwiglu E{ACT, DFF};
        pg8::gemm_phase<pg8::EpiSwiglu, pg8::StaticOrder, true, true>(lds + RING_OFF, g, S, E);
    } SEAM(10);
    if (IN(11)) {
        pg8::Gemm g{ACT, (const bf16*)(ws + WS_W2O), M, D, DFF, DFF, DFF, 0}; pg8::StaticOrder S; S.init(M, D, G, bx);
        pg8::EpiF32 E{Y, D};
        pg8::gemm_phase<pg8::EpiF32, pg8::StaticOrder, true, true>(lds + RING_OFF, g, S, E);
    } SEAM(11);
    if (IN(12)) { phase_rownorm(args, 2, args.out, false, lane, wave, vcu, G); }
#undef IN
#undef SEAM
}

#if DBG_DUMP
__global__ void dbg_dump(const unsigned short* buf, int ld, int coff, float* out) {
    const size_t i = (size_t)blockIdx.x * blockDim.x + threadIdx.x; const size_t m = i >> 10; const int c = (int)(i & 1023);
    out[i] = __uint_as_float((unsigned)buf[m * ld + coff + c] << 16);
}
#endif
extern "C" void kernel_launch(void* const* d_in, const int* in_sizes, int n_in, void* d_out, int out_size, void* d_ws, size_t ws_size, hipStream_t stream) {
    static int grid = 0;
    if (grid == 0) {
        if (n_in != 20 || in_sizes[0] != M * D || out_size != M * D || ws_size < WS_END) { fprintf(stderr, "kernel_launch: unexpected shapes (n_in %d, in0 %d, out %d, ws %zu); nothing launched\n", n_in, n_in > 0 ? in_sizes[0] : -1, out_size, ws_size); grid = -1; return; }
        int dev = 0, cus = 0, per_cu = 0;
        if (hipGetDevice(&dev) != hipSuccess || hipDeviceGetAttribute(&cus, hipDeviceAttributeMultiprocessorCount, dev) != hipSuccess) { fprintf(stderr, "kernel_launch: device query failed\n"); grid = -1; return; }
        if (hipFuncSetAttribute((const void*)fwd_kernel, hipFuncAttributeMaxDynamicSharedMemorySize, LDS_BYTES) != hipSuccess) { fprintf(stderr, "kernel_launch: hipFuncSetAttribute failed\n"); grid = -1; return; }
        if (hipOccupancyMaxActiveBlocksPerMultiprocessor(&per_cu, (const void*)fwd_kernel, NTHREADS, LDS_BYTES) != hipSuccess || per_cu < 1)
            fprintf(stderr, "kernel_launch: note: occupancy query reports %d workgroups per CU\n", per_cu);
        (void)hipGetLastError();
        grid = cus;
    }
    if (grid < 0) return;
    if (hipMemsetAsync((char*)d_ws + WS_CTL, 0, CTL_ZERO_BYTES, stream) != hipSuccess) { fprintf(stderr, "kernel_launch: memset failed\n"); return; }
    Args a{};
    for (int i = 0; i < 20; ++i) a.in[i] = (const float*)d_in[i];
    a.out = (float*)d_out; a.ws = (unsigned char*)d_ws;
    for (int li = 0; li < N_LAUNCHES; ++li) {
        a.ph_lo = (N_LAUNCHES == 1) ? 0 : li; a.ph_hi = (N_LAUNCHES == 1) ? DBG_STOP : li + 1; if (li >= DBG_STOP) break;
        hipLaunchKernelGGL(fwd_kernel, dim3(grid), dim3(NTHREADS), LDS_BYTES, stream, a);
        const hipError_t le = hipPeekAtLastError();
        if (le != hipSuccess) { fprintf(stderr, "kernel_launch: launch %d failed: %s\n", li, hipGetErrorName(le)); break; }
    }
#if DBG_DUMP == 1
    hipLaunchKernelGGL(dbg_dump, dim3(M * D / 256), dim3(256), 0, stream, (const unsigned short*)((char*)d_ws + WS_XN), 1024, 0, (float*)d_out);
#elif DBG_DUMP == 3
    hipLaunchKernelGGL(dbg_dump, dim3(M * D / 256), dim3(256), 0, stream, (const unsigned short*)((char*)d_ws + WS_CAT), 1024, 0, (float*)d_out);
#elif DBG_DUMP == 4
    hipLaunchKernelGGL(dbg_dump, dim3(M * D / 256), dim3(256), 0, stream, (const unsigned short*)((char*)d_ws + WS_MIXED), 1024, 0, (float*)d_out);
#elif DBG_DUMP == 6
    hipLaunchKernelGGL(dbg_dump, dim3(M * D / 256), dim3(256), 0, stream, (const unsigned short*)((char*)d_ws + WS_ZG), 1024, 0, (float*)d_out);
#elif DBG_DUMP == 8
    hipLaunchKernelGGL(dbg_dump, dim3(M * D / 256), dim3(256), 0, stream, (const unsigned short*)((char*)d_ws + WS_GATE), 2048, 0, (float*)d_out);
#elif DBG_DUMP == 7
    hipLaunchKernelGGL(dbg_dump, dim3(M * D / 256), dim3(256), 0, stream, (const unsigned short*)((char*)d_ws + WS_GATE), 2048, 1024, (float*)d_out);
#elif DBG_DUMP == 2
    hipLaunchKernelGGL(dbg_dump, dim3(M * D / 256), dim3(256), 0, stream, (const unsigned short*)((char*)d_ws + WS_ACT), DFF, 0, (float*)d_out);
#endif
}
```
